# Optimizing an MI355X kernel written in HIP

```python
import jax, jax.numpy as jnp
from jax import lax
import numpy as np

D_MODEL = 1024
BATCH = 2
SEQ = 8192
DEPTH = 1
DEC_BATCH = 4
DEC_SEQ = 8192
PAST_LEN = 128

HG_HEADS = 8
HG_KDIM = 128
HG_VDIM = D_MODEL // HG_HEADS
HG_FDIM = HG_HEADS * HG_KDIM
HG_IDIM = HG_HEADS * HG_VDIM
CHUNK = 64
ATTN_GROUPS = ((128, 1), (512, 4), (2048, 16))
ATTN_HEADS = 4
ATTN_HEAD_DIM = 128
ATTN_WIDTH = ATTN_HEADS * ATTN_HEAD_DIM
ROT_DIM = ATTN_HEAD_DIM // 4
ROPE_THETA = 500000.0
N_MEM = 256
XA_HEADS = 4
XA_HEAD_DIM = D_MODEL // XA_HEADS
D_FF = 4 * D_MODEL
RMS_EPS = 1e-6

IN_SIZES = (HG_FDIM, HG_FDIM, HG_FDIM, HG_IDIM, HG_IDIM) + (ATTN_WIDTH,) * (3 * len(ATTN_GROUPS)) + (D_MODEL, D_MODEL)
N_IN = sum(IN_SIZES)
IN_SPLITS = [int(c) for c in np.cumsum(IN_SIZES)[:-1]]

kernel_name = "hgrn2_dilated_attn_parallel_encoder"


def _rmsnorm(x, g):
    xf = x.astype(jnp.float32)
    y = xf * lax.rsqrt(jnp.mean(xf * xf, axis=-1, keepdims=True) + RMS_EPS)
    return (y * g.astype(jnp.float32)).astype(x.dtype)


def _gla_chunk_scan(q, k, logf, v):
    B, H, S, K = q.shape
    V = v.shape[-1]
    n = S // CHUNK

    def chunks(t):
        return t.reshape(B, H, n, CHUNK, t.shape[-1]).transpose(2, 0, 1, 3, 4)

    causal = jnp.tril(jnp.ones((CHUNK, CHUNK), dtype=bool))[:, :, None]

    def step(S0, xs):
        qb, kb, fb, vb = xs
        b = jnp.cumsum(fb, axis=2)
        o_inter = jnp.einsum('bhck,bhkv->bhcv', qb * jnp.exp(b), S0)
        diff = b[:, :, :, None, :] - b[:, :, None, :, :]
        decay = jnp.exp(jnp.where(causal, diff, -jnp.inf))
        attn = jnp.einsum('bhtk,bhsk,bhtsk->bhts', qb, kb, decay)
        o_intra = jnp.einsum('bhts,bhsv->bhtv', attn, vb)
        b_last = b[:, :, -1:, :]
        S_new = jnp.exp(b_last[:, :, 0, :])[..., None] * S0 + jnp.einsum(
            'bhsk,bhsv->bhkv', kb * jnp.exp(b_last - b), vb)
        return S_new, o_inter + o_intra

    S0 = jnp.zeros((B, H, K, V), jnp.float32)
    _, o = lax.scan(step, S0, (chunks(q), chunks(k), chunks(logf), chunks(v)))
    return o.transpose(1, 2, 0, 3, 4).reshape(B, H, S, V)


def _hgrn2_bidir(q, f_fwd, f_bwd, i, g, lb, gnorm_g):
    B, S, _ = q.shape
    f32 = jnp.float32

    def heads(t, d):
        return t.reshape(B, S, HG_HEADS, d).transpose(0, 2, 1, 3).astype(f32)

    qh = jax.nn.silu(heads(q, HG_KDIM))
    vh = heads(i, HG_VDIM)
    lbh = lb.astype(f32).reshape(2, HG_HEADS, 1, HG_KDIM)

    def gate(fpre, lbd):
        fg = lbd + (1.0 - lbd) * jax.nn.sigmoid(heads(fpre, HG_KDIM))
        return 1.0 - fg, jnp.log(fg)

    k_f, lf_f = gate(f_fwd, lbh[0])
    k_b, lf_b = gate(f_bwd, lbh[1])
    o_f = _gla_chunk_scan(qh, k_f, lf_f, vh)
    rev = lambda t: jnp.flip(t, axis=2)
    o_b = rev(_gla_chunk_scan(rev(qh), rev(k_b), rev(lf_b), rev(vh)))
    o = (o_f + o_b).transpose(0, 2, 1, 3)
    o = _rmsnorm(o, gnorm_g) * jax.nn.silu(g.reshape(B, S, HG_HEADS, HG_VDIM).astype(f32))
    return o.reshape(B, S, HG_IDIM).astype(q.dtype)


def _partial_rotary(t, pos):
    half = ROT_DIM // 2
    inv = ROPE_THETA ** (-jnp.arange(half, dtype=jnp.float32) * 2.0 / ROT_DIM)
    ang = pos.astype(jnp.float32)[:, None] * inv[None, :]
    cos = jnp.cos(ang)[None, :, None, :]
    sin = jnp.sin(ang)[None, :, None, :]
    tr = t[..., :ROT_DIM].astype(jnp.float32)
    x1, x2 = tr[..., :half], tr[..., half:]
    rot = jnp.concatenate([x1 * cos - x2 * sin, x2 * cos + x1 * sin], axis=-1)
    return jnp.concatenate([rot.astype(t.dtype), t[..., ROT_DIM:]], axis=-1)


def _dilated_window_attention(q, k, v, span, dil):
    B, S, H, Dh = q.shape
    L = S // dil
    N = B * dil
    blk = span
    nb = -(-L // blk)
    Lp = nb * blk

    def residue(t):
        return t.reshape(B, L, dil, H, Dh).transpose(0, 2, 1, 3, 4).reshape(N, L, H, Dh)

    qr, kr, vr = residue(q), residue(k), residue(v)
    qb = jnp.pad(qr, ((0, 0), (0, Lp - L), (0, 0), (0, 0))).reshape(N, nb, blk, H, Dh)

    def kv_blocks(t):
        tp = jnp.pad(t, ((0, 0), (blk, Lp - L + blk), (0, 0), (0, 0))).reshape(N, nb + 2, blk, H, Dh)
        return jnp.concatenate([tp[:, :-2], tp[:, 1:-1], tp[:, 2:]], axis=2)

    kb, vb = kv_blocks(kr), kv_blocks(vr)
    m_q = jnp.arange(nb)[:, None, None] * blk + jnp.arange(blk)[None, :, None]
    m_k = jnp.arange(nb)[:, None, None] * blk - blk + jnp.arange(3 * blk)[None, None, :]
    mask = ((jnp.abs(m_k - m_q) <= span) & (m_k >= 0) & (m_k < L)) | (m_k == m_q)
    s = jnp.einsum('nbqhd,nbkhd->nbhqk', qb, kb).astype(jnp.float32) * (Dh ** -0.5)
    s = jnp.where(mask[None, :, None], s, -jnp.inf)
    lse = jax.nn.logsumexp(s, axis=-1)
    p = jnp.exp(s - lse[..., None])
    o = jnp.einsum('nbhqk,nbkhd->nbqhd', p.astype(v.dtype), vb).reshape(N, Lp, H, Dh)[:, :L]
    lse = lse.transpose(0, 1, 3, 2).reshape(N, Lp, H)[:, :L]
    o = o.reshape(B, dil, L, H, Dh).transpose(0, 2, 1, 3, 4).reshape(B, S, H, Dh)
    lse = lse.reshape(B, dil, L, H).transpose(0, 2, 1, 3).reshape(B, S, H)
    return o, lse


def _memory_cross_attention(u, mem_n, w_q, w_kv, w_o):
    B, S, _ = u.shape
    M = mem_n.shape[1]
    q = (u @ w_q).reshape(B, S, XA_HEADS, XA_HEAD_DIM)
    k, v = jnp.split(mem_n @ w_kv, 2, axis=-1)
    k = k.reshape(B, M, XA_HEADS, XA_HEAD_DIM)
    v = v.reshape(B, M, XA_HEADS, XA_HEAD_DIM)
    s = jnp.einsum('bshd,bmhd->bhsm', q, k).astype(jnp.float32) * (XA_HEAD_DIM ** -0.5)
    p = jax.nn.softmax(s, axis=-1)
    o = jnp.einsum('bhsm,bmhd->bshd', p.astype(v.dtype), v).reshape(B, S, D_MODEL)
    return o @ w_o


def _encode(x, mem, mix_norm_g, w_in, hgrn_lb_logits, hgrn_gnorm_g, w_hgrn_o, w_attn_o, w_out,
            xa_norm_g, mem_norm_g, w_xq, w_xkv, w_xo, ffn_norm_g, w_ffn1, w_ffn2, final_norm_g):
    B, S, _ = x.shape
    pos = jnp.arange(S)
    lb_all = jnp.cumsum(jax.nn.softmax(hgrn_lb_logits.astype(jnp.float32), axis=1), axis=1)
    h = x
    for l in range(DEPTH):
        u = _rmsnorm(h, mix_norm_g[l])
        parts = jnp.split(u @ w_in[l], IN_SPLITS, axis=-1)
        hq, hf_f, hf_b, hi, hg = parts[:5]
        attn_parts = parts[5:5 + 3 * len(ATTN_GROUPS)]
        gate_h, gate_a = parts[5 + 3 * len(ATTN_GROUPS):]

        y_h = _hgrn2_bidir(hq, hf_f, hf_b, hi, hg, lb_all[:, l], hgrn_gnorm_g[l]) @ w_hgrn_o[l]

        outs, lses = [], []
        for gi, (win, dil) in enumerate(ATTN_GROUPS):
            qg, kg, vg = [t.reshape(B, S, ATTN_HEADS, ATTN_HEAD_DIM) for t in attn_parts[3 * gi:3 * gi + 3]]
            o, lse = _dilated_window_attention(_partial_rotary(qg, pos), _partial_rotary(kg, pos), vg,
                                               (win // 2) // dil, dil)
            outs.append(o)
            lses.append(lse)
        wts = jax.nn.softmax(jnp.stack(lses), axis=0)
        attn = jnp.einsum('gbsh,gbshd->bshd', wts, jnp.stack(outs).astype(jnp.float32))
        y_a = attn.reshape(B, S, ATTN_WIDTH).astype(h.dtype) @ w_attn_o[l]

        merged = jax.nn.sigmoid(gate_h) * y_h + jax.nn.sigmoid(gate_a) * y_a
        h = h + merged @ w_out[l]
        h = h + _memory_cross_attention(_rmsnorm(h, xa_norm_g[l]), _rmsnorm(mem, mem_norm_g[l]),
                                        w_xq[l], w_xkv[l], w_xo[l])
        u = _rmsnorm(h, ffn_norm_g[l])
        h = h + jnp.square(jax.nn.relu(u @ w_ffn1[l])) @ w_ffn2[l]
    return _rmsnorm(h, final_norm_g)


def setup_inputs(seed: int = 0) -> dict:
    key = jax.random.key(seed)
    ks = jax.random.split(key, 24)
    f32 = jnp.float32

    def w(k, shape, fan_in):
        return jax.random.normal(k, shape, f32) * (fan_in ** -0.5)

    def gain(k, shape):
        return 1.0 + 0.02 * jax.random.normal(k, shape, f32)

    return {
        "x_prompt": jax.random.normal(ks[0], (BATCH, SEQ, D_MODEL), f32),
        "x_sample": jax.random.normal(ks[1], (DEC_BATCH, DEC_SEQ, D_MODEL), f32),
        "mem_prompt": jax.random.normal(ks[2], (BATCH, N_MEM, D_MODEL), f32),
        "mem_sample": jax.random.normal(ks[3], (DEC_BATCH, N_MEM, D_MODEL), f32),
        "mix_norm_g": gain(ks[4], (DEPTH, D_MODEL)),
        "w_in": w(ks[5], (DEPTH, D_MODEL, N_IN), D_MODEL),
        "hgrn_lb_logits": 0.5 * jax.random.normal(ks[6], (2, DEPTH + 1, HG_FDIM), f32),
        "hgrn_gnorm_g": gain(ks[7], (DEPTH, HG_VDIM)),
        "w_hgrn_o": w(ks[8], (DEPTH, HG_IDIM, D_MODEL), HG_IDIM),
        "w_attn_o": w(ks[9], (DEPTH, ATTN_WIDTH, D_MODEL), ATTN_WIDTH),
        "w_out": w(ks[10], (DEPTH, D_MODEL, D_MODEL), D_MODEL),
        "xa_norm_g": gain(ks[11], (DEPTH, D_MODEL)),
        "mem_norm_g": gain(ks[12], (DEPTH, D_MODEL)),
        "w_xq": w(ks[13], (DEPTH, D_MODEL, XA_HEADS * XA_HEAD_DIM), D_MODEL),
        "w_xkv": w(ks[14], (DEPTH, D_MODEL, 2 * XA_HEADS * XA_HEAD_DIM), D_MODEL),
        "w_xo": w(ks[15], (DEPTH, XA_HEADS * XA_HEAD_DIM, D_MODEL), XA_HEADS * XA_HEAD_DIM),
        "ffn_norm_g": gain(ks[16], (DEPTH, D_MODEL)),
        "w_ffn1": w(ks[17], (DEPTH, D_MODEL, D_FF), D_MODEL),
        "w_ffn2": w(ks[18], (DEPTH, D_FF, D_MODEL), D_FF),
        "final_norm_g": gain(ks[19], (D_MODEL,)),
    }


def reference(x_prompt, x_sample, mem_prompt, mem_sample, mix_norm_g, w_in, hgrn_lb_logits, hgrn_gnorm_g,
              w_hgrn_o, w_attn_o, w_out, xa_norm_g, mem_norm_g, w_xq, w_xkv, w_xo, ffn_norm_g, w_ffn1,
              w_ffn2, final_norm_g):
    y_prompt = _encode(x_prompt, mem_prompt, mix_norm_g, w_in, hgrn_lb_logits, hgrn_gnorm_g, w_hgrn_o,
                       w_attn_o, w_out, xa_norm_g, mem_norm_g, w_xq, w_xkv, w_xo, ffn_norm_g, w_ffn1,
                       w_ffn2, final_norm_g)
    y_sample = _encode(x_sample, mem_sample, mix_norm_g, w_in, hgrn_lb_logits, hgrn_gnorm_g, w_hgrn_o,
                       w_attn_o, w_out, xa_norm_g, mem_norm_g, w_xq, w_xkv, w_xo, ffn_norm_g, w_ffn1,
                       w_ffn2, final_norm_g)
    return (y_prompt, y_sample)
```

```cpp
#include <hip/hip_runtime.h>
#include <hip/hip_cooperative_groups.h>
#include <cstdio>
#include <cstdint>
namespace cg = cooperative_groups;

#ifndef DBL
#define DBL 0
#endif
#ifndef ONE_LAUNCH
#define ONE_LAUNCH 1
#endif

#define DI __device__ __forceinline__
#define LAS __attribute__((address_space(3)))
typedef unsigned short bf16;
typedef short bf16x8 __attribute__((ext_vector_type(8)));
typedef short s16x4 __attribute__((ext_vector_type(4)));
typedef float f32x4 __attribute__((ext_vector_type(4)));
typedef float f32x2 __attribute__((ext_vector_type(2)));
typedef unsigned u32x4 __attribute__((ext_vector_type(4)));
typedef unsigned u32x2 __attribute__((ext_vector_type(2)));

constexpr int DM = 1024, SEQ = 8192, NSEQ = 6, TTOK = NSEQ * SEQ, BROWS = 2 * SEQ  , NBATCH = 3;
constexpr int NIN = 11776, FF = 4096, NMEM = 256;
constexpr int C_Q = 0, C_FF = 1024, C_FB = 2048, C_V = 3072, C_G = 4096, C_ATT = 5120, C_GH = 9728, C_GA = 10752;
constexpr size_t PE1 = (size_t)BROWS * 1024, PE2 = (size_t)BROWS * 512;
constexpr size_t OFF_Q = 0, OFF_FF = PE1, OFF_V = 3 * PE1, OFF_G = 4 * PE1, OFF_ATT0 = 5 * PE1, OFF_GH = 5 * PE1 + 9 * PE2, OFF_GA = OFF_GH + PE1;
constexpr float RMS_EPS = 1e-6f;
constexpr float QSCALE_A = 0.08838834764831845f * 1.4426950408889634f;
constexpr float QSCALE_X = 0.0625f * 1.4426950408889634f;

constexpr size_t MiB = 1u << 20;
constexpr int LDS_BYTES_ = 147456, LDS_BYTES = LDS_BYTES_;
constexpr size_t WS_WIN = 0, WS_WHO = 23 * MiB, WS_WAO = 25 * MiB, WS_WOUT = 26 * MiB, WS_WXQ = 28 * MiB, WS_WXKV = 30 * MiB, WS_WXO = 34 * MiB,
                 WS_WF1 = 36 * MiB, WS_WF2 = 44 * MiB;
constexpr size_t WS_LB = 52 * MiB, WS_ROPE = 52 * MiB + 65536, WS_SEGD = 53 * MiB + 524288, WS_MEMN = 54 * MiB, WS_KMEM = 57 * MiB, WS_VTMEM = 60 * MiB,
                 WS_LSE = 63 * MiB, WS_SEGL = 64 * MiB, WS_U = 80 * MiB, WS_P = 112 * MiB, WS_CTL = 480 * MiB, WS_END = 485 * MiB;
constexpr size_t CTL_BYTES = 16384;
constexpr size_t WS_SS = 481 * MiB;
constexpr int LDS_BARST = LDS_BYTES_ - 64;


DI float bf2f(unsigned short h) { return __uint_as_float((unsigned)h << 16); }
DI unsigned short f2bf(float f) { unsigned u = __float_as_uint(f); return (unsigned short)((u + 0x7fffu + ((u >> 16) & 1u)) >> 16); }
DI unsigned pk2(float lo, float hi) { return (unsigned)f2bf(lo) | ((unsigned)f2bf(hi) << 16); }
DI float lo_f(unsigned u) { return __uint_as_float(u << 16); }
DI float hi_f(unsigned u) { return __uint_as_float(u & 0xffff0000u); }
DI float sigmoidf_(float x) { return __builtin_amdgcn_rcpf(1.0f + __builtin_amdgcn_exp2f(x * -1.4426950408889634f)); }
DI unsigned cvtpk(float lo, float hi) { unsigned r; asm volatile("v_cvt_pk_bf16_f32 %0, %1, %2" : "=v"(r) : "v"(lo), "v"(hi)); return r; }
DI float ex2(float x) { return __builtin_amdgcn_exp2f(x); }
DI float wave_sum(float v) {
#pragma unroll
    for (int o = 1; o < 64; o <<= 1) v += __shfl_xor(v, o);
    return v;
}
#define MFMA16(a, b, c) __builtin_amdgcn_mfma_f32_16x16x32_bf16((a), (b), (c), 0, 0, 0)

namespace pg8 {
constexpr int BM = 256, BK = 64, HALF = 128, HTB = HALF * BK * 2, STAGE_BYTES = 8 * HTB, NXCD = 8, WGM = 8;
DI int lds_byte(int r, int c) { const int st = (r >> 4) * 2 + (c >> 5), rr = r & 15, cc = c & 31, ob = rr * 64 + cc * 2; return st * 1024 + (ob ^ (((ob >> 9) & 1) << 5)); }
DI void stage_rc(int b, int& R, int& C) { const int st = b / 1024, sb = b % 1024, swz = sb ^ (((sb >> 9) & 1) << 5); R = (st >> 1) * 16 + swz / 64; C = (st & 1) * 32 + (swz % 64) / 2; }
DI int perm32(int rho) { const int n = rho >> 4, i = rho & 15; return 8 * (i >> 2) + 4 * n + (i & 3); }
struct Unit { int pm, pn; };
struct Gemm { const bf16* A; const bf16* Bt; int M, N, K, lda; };
struct StaticOrder {
    int nM, nN, nwg, G, c;
    DI void init(int M, int N, int G_, int c_) { nM = M / BM; nN = N / BM; nwg = nM * nN; G = G_; c = c_; }
    DI bool next(int i, Unit& u) const {
        const long L = (long)i * G + c; if (L >= nwg) return false;
        int wgid = (int)L; { const int q = nwg / NXCD, r = nwg % NXCD, xcd = wgid % NXCD, off = wgid / NXCD; wgid = (xcd < r ? xcd * (q + 1) : r * (q + 1) + (xcd - r) * q) + off; }
        const int nig = WGM * nN, gid = wgid / nig, fm = gid * WGM, gsz = (nM - fm) < WGM ? (nM - fm) : WGM;
        u.pm = fm + ((wgid % nig) % gsz); u.pn = (wgid % nig) / gsz; return true;
    }
};
DI unsigned cvt_pk_bf16(float lo, float hi) { unsigned r; asm volatile("v_cvt_pk_bf16_f32 %0, %1, %2" : "=v"(r) : "v"(lo), "v"(hi)); return r; }

template <class Epi, bool ALIGN_EPI>
DI void gemm_phase(LAS unsigned char* lds, const Gemm g, const StaticOrder& S, const Epi& E, const int tid) {
    const int wid = __builtin_amdgcn_readfirstlane(tid >> 6), lane = tid & 63, wr = wid >> 2, wc = wid & 3, fr = lane & 15, fq = lane >> 4;
    const int K = g.K, nt = K / BK;
    unsigned voffA[2], voffB[2];
#pragma unroll
    for (int i = 0; i < 2; ++i) { int R, C; stage_rc(tid * 16 + i * 8192, R, C); const int Rb = Epi::PERM ? ((R & ~31) + perm32(R & 31)) : R;
        voffA[i] = (unsigned)(R * g.lda + C) * 2u; voffB[i] = (unsigned)(Rb * K + C) * 2u; }
    const size_t kstep = (size_t)(BK * 2);
    const size_t hstepA = (size_t)HALF * g.lda * 2, hstepB = (size_t)HALF * K * 2;
    const size_t tstepA = 2 * hstepA, tstepB = 2 * hstepB;
    const unsigned ldsw = (unsigned)wid * 1024u;
    const int aoff = lds_byte(wr * 64 + fr, fq * 8), boff = lds_byte(wc * 32 + fr, fq * 8);
#define PG8_SA(b, h) (((b) * 2 + (h)) * HTB)
#define PG8_SB(b, h) ((4 + (b) * 2 + (h)) * HTB)
#define PG8_STAGE(bufoff, gbase, voff) do { _Pragma("unroll") for (int _i = 0; _i < 2; ++_i) \
        __builtin_amdgcn_global_load_lds((const unsigned*)((const char*)(gbase) + (voff)[_i]), (LAS unsigned*)(lds + (bufoff) + ldsw + _i * 8192), 16, 0, 0); } while (0)
#define PG8_LDA(dst, b, h) do { _Pragma("unroll") for (int m = 0; m < 4; ++m) _Pragma("unroll") for (int k = 0; k < 2; ++k) dst[m][k] = *(const LAS bf16x8*)(lds + PG8_SA(b, h) + aoff + m * 2048 + k * 1024); } while (0)
#define PG8_LDB(dst, b, h) do { _Pragma("unroll") for (int n = 0; n < 2; ++n) _Pragma("unroll") for (int k = 0; k < 2; ++k) dst[n][k] = *(const LAS bf16x8*)(lds + PG8_SB(b, h) + boff + n * 2048 + k * 1024); } while (0)
#define PG8_MMA(ai, bj, At, Bt) do { __builtin_amdgcn_s_setprio(1); _Pragma("unroll") for (int m = 0; m < 4; ++m) _Pragma("unroll") for (int n = 0; n < 2; ++n) _Pragma("unroll") for (int k = 0; k < 2; ++k) \
        acc[ai][bj][m][n] = __builtin_amdgcn_mfma_f32_16x16x32_bf16(Bt[n][k], At[m][k], acc[ai][bj][m][n], 0, 0, 0); __builtin_amdgcn_s_setprio(0); } while (0)
#define PG8_WAIT_V(n) asm volatile("s_waitcnt vmcnt(" #n ")" ::: "memory")
#define PG8_WAIT_L(n) asm volatile("s_waitcnt lgkmcnt(" #n ")" ::: "memory")
#define PG8_BAR __builtin_amdgcn_s_barrier()
#define PG8_SCHED __builtin_amdgcn_sched_barrier(0)
    Unit cur, nxt; int ui = 0;
    if (!S.next(0, cur)) return;
    f32x4 acc[2][2][4][2];
#pragma unroll
    for (int a = 0; a < 2; ++a)
#pragma unroll
        for (int b = 0; b < 2; ++b)
#pragma unroll
            for (int m = 0; m < 4; ++m)
#pragma unroll
                for (int n = 0; n < 2; ++n) acc[a][b][m][n] = (f32x4){0.f, 0.f, 0.f, 0.f};
    bf16x8 At[4][2], B0[2][2], B1[2][2];
    const char* cA = (const char*)g.A + (size_t)cur.pm * tstepA; const char* cB = (const char*)g.Bt + (size_t)cur.pn * tstepB;
    PG8_STAGE(PG8_SB(0, 0), cB, voffB); PG8_STAGE(PG8_SB(0, 1), cB + hstepB, voffB); PG8_STAGE(PG8_SA(0, 0), cA, voffA); PG8_STAGE(PG8_SA(0, 1), cA + hstepA, voffA);
    if (wr == 1) PG8_BAR;
    PG8_WAIT_V(2); PG8_BAR;
    PG8_STAGE(PG8_SB(1, 0), cB + kstep, voffB); PG8_STAGE(PG8_SA(1, 0), cA + kstep, voffA); PG8_STAGE(PG8_SB(1, 1), cB + hstepB + kstep, voffB);
    PG8_WAIT_V(6); PG8_BAR;
    for (;;) {
        const bool has_next = S.next(ui + 1, nxt);
        const char* nA = has_next ? (const char*)g.A + (size_t)nxt.pm * tstepA : cA; const char* nB = has_next ? (const char*)g.Bt + (size_t)nxt.pn * tstepB : cB;
        for (int t = 0; t < nt; t += 2) {
            const bool last = (t == nt - 2);
            const char* a1 = cA + (size_t)(t + 1) * kstep;
            const char* a2 = last ? nA : cA + (size_t)(t + 2) * kstep; const char* b2 = last ? nB : cB + (size_t)(t + 2) * kstep;
            const char* a3 = a2 + kstep; const char* b3 = b2 + kstep;
            PG8_LDB(B0, 0, 0); PG8_LDB(B1, 0, 1); PG8_SCHED; PG8_LDA(At, 0, 0); PG8_STAGE(PG8_SA(1, 1), a1 + hstepA, voffA);
            PG8_WAIT_V(8); PG8_WAIT_L(0); PG8_BAR; PG8_MMA(0, 0, At, B0); PG8_MMA(0, 1, At, B1); PG8_BAR; PG8_SCHED;
            PG8_LDA(At, 0, 1); PG8_STAGE(PG8_SB(0, 0), b2, voffB); PG8_STAGE(PG8_SB(0, 1), b2 + hstepB, voffB); PG8_STAGE(PG8_SA(0, 0), a2, voffA);
            PG8_WAIT_V(8); PG8_WAIT_L(0); PG8_BAR; PG8_MMA(1, 0, At, B0); PG8_MMA(1, 1, At, B1); PG8_BAR; PG8_SCHED;
            PG8_LDB(B0, 1, 0); PG8_LDB(B1, 1, 1); PG8_SCHED; PG8_LDA(At, 1, 0); PG8_STAGE(PG8_SA(0, 1), a2 + hstepA, voffA);
            PG8_WAIT_V(8); PG8_WAIT_L(0); PG8_BAR; PG8_MMA(0, 0, At, B0); PG8_MMA(0, 1, At, B1); PG8_BAR; PG8_SCHED;
            PG8_LDA(At, 1, 1); PG8_STAGE(PG8_SB(1, 0), b3, voffB); PG8_STAGE(PG8_SB(1, 1), b3 + hstepB, voffB); PG8_STAGE(PG8_SA(1, 0), a3, voffA);
            PG8_WAIT_V(8); PG8_WAIT_L(0); PG8_BAR; PG8_MMA(1, 0, At, B0); PG8_MMA(1, 1, At, B1); PG8_BAR; PG8_SCHED;
        }
        if constexpr (ALIGN_EPI) { if (wr == 0) PG8_BAR; }
        E(acc, cur, wr, wc, fr, fq);
        if (!has_next) break;
#pragma unroll
        for (int a = 0; a < 2; ++a)
#pragma unroll
            for (int b = 0; b < 2; ++b)
#pragma unroll
                for (int m = 0; m < 4; ++m)
#pragma unroll
                    for (int n = 0; n < 2; ++n) acc[a][b][m][n] = (f32x4){0.f, 0.f, 0.f, 0.f};
        cur = nxt; cA = nA; cB = nB; ++ui;
        if constexpr (ALIGN_EPI) { if (wr == 1) PG8_BAR; }
    }
    PG8_WAIT_V(0);
    if constexpr (!ALIGN_EPI) { if (wr == 0) PG8_BAR; }
    PG8_BAR;
#undef PG8_SA
#undef PG8_SB
#undef PG8_STAGE
#undef PG8_LDA
#undef PG8_LDB
#undef PG8_MMA
#undef PG8_WAIT_V
#undef PG8_WAIT_L
#undef PG8_BAR
#undef PG8_SCHED
}

struct EpiIn {
    static constexpr bool PERM = true;
    bf16* P; const float* lb; const float* rope;
    DI void operator()(const f32x4 (&acc)[2][2][4][2], const Unit& u, int wr, int wc, int fr, int fq) const {
        const int seg = u.pn >> 1;
        int type, dir = 0;
        if (seg < 2) type = 0; else if (seg < 6) { type = 1; dir = (seg >= 4) ? 1 : 0; } else if (seg < 8) type = 2; else if (seg < 10) type = 0;
        else if (seg < 19) { const int t = (seg - 10) % 3; type = (t == 0) ? 4 : ((t == 1) ? 5 : 2); } else type = 3;
#pragma unroll
        for (int ai = 0; ai < 2; ++ai)
#pragma unroll
            for (int m = 0; m < 4; ++m) {
                const int row = u.pm * BM + ai * HALF + wr * 64 + m * 16 + fr;
                const int c0t = u.pn * BM;
                size_t toff; int pitch, lc;
                if (c0t < C_ATT) { toff = (size_t)(c0t >> 10) * PE1; pitch = 1024; lc = c0t & 1023; }
                else if (c0t < C_GH) { toff = OFF_ATT0 + (size_t)((c0t - C_ATT) >> 9) * PE2; pitch = 512; lc = (c0t - C_ATT) & 511; }
                else { toff = OFF_GH + (size_t)((c0t - C_GH) >> 10) * PE1; pitch = 1024; lc = (c0t - C_GH) & 1023; }
                bf16* rowp = P + toff + (size_t)row * pitch + lc;
#pragma unroll
                for (int bj = 0; bj < 2; ++bj) {
                    const int col0 = u.pn * BM + bj * HALF + wc * 32 + 8 * fq;
                    f32x4 v0 = acc[ai][bj][m][0], v1 = acc[ai][bj][m][1];
                    if (type == 0) {
#pragma unroll
                        for (int i = 0; i < 4; ++i) { v0[i] = v0[i] * sigmoidf_(v0[i]); v1[i] = v1[i] * sigmoidf_(v1[i]); }
                    } else if (type == 1) {
                        const float* lbp = lb + dir * 1024 + (col0 - (C_FF + 1024 * dir));
                        const f32x4 l0 = *(const f32x4*)lbp, l1 = *(const f32x4*)(lbp + 4);
#pragma unroll
                        for (int i = 0; i < 4; ++i) { v0[i] = __logf(l0[i] + (1.0f - l0[i]) * sigmoidf_(v0[i])); v1[i] = __logf(l1[i] + (1.0f - l1[i]) * sigmoidf_(v1[i])); }
                    } else if (type == 3) {
#pragma unroll
                        for (int i = 0; i < 4; ++i) { v0[i] = sigmoidf_(v0[i]); v1[i] = sigmoidf_(v1[i]); }
                    } else if (type == 4 || type == 5) {
                        if (wc == 0) {
                            const int pos = row & (SEQ - 1);
                            const float* rp = rope + ((size_t)pos * 16 + 8 * (fq & 1)) * 2;
                            const f32x4 ca = *(const f32x4*)rp, cb = *(const f32x4*)(rp + 4), cc = *(const f32x4*)(rp + 8), cd = *(const f32x4*)(rp + 12);
                            const float c[8] = {ca[0], ca[2], cb[0], cb[2], cc[0], cc[2], cd[0], cd[2]}, sn[8] = {ca[1], ca[3], cb[1], cb[3], cc[1], cc[3], cd[1], cd[3]};
                            const float sg = (fq < 2) ? -1.0f : 1.0f;
#pragma unroll
                            for (int i = 0; i < 4; ++i) {
                                const float p0 = __shfl_xor(v0[i], 32), p1 = __shfl_xor(v1[i], 32);
                                v0[i] = v0[i] * c[i] + sg * p0 * sn[i]; v1[i] = v1[i] * c[4 + i] + sg * p1 * sn[4 + i];
                            }
                        }
                        if (type == 4) { v0 = v0 * QSCALE_A; v1 = v1 * QSCALE_A; }
                    }
                    u32x4 w; w.x = cvt_pk_bf16(v0[0], v0[1]); w.y = cvt_pk_bf16(v0[2], v0[3]); w.z = cvt_pk_bf16(v1[0], v1[1]); w.w = cvt_pk_bf16(v1[2], v1[3]);
                    *(u32x4*)(rowp + bj * HALF + wc * 32 + 8 * fq) = w;
                }
            }
    }
};
struct EpiKV {
    static constexpr bool PERM = false;
    bf16* Km; bf16* Vt;
    DI void operator()(const f32x4 (&acc)[2][2][4][2], const Unit& u, int wr, int wc, int fr, int fq) const {
#pragma unroll
        for (int ai = 0; ai < 2; ++ai)
#pragma unroll
            for (int m = 0; m < 4; ++m) {
                const int row = u.pm * BM + ai * HALF + wr * 64 + m * 16 + fr;
#pragma unroll
                for (int bj = 0; bj < 2; ++bj)
#pragma unroll
                    for (int n = 0; n < 2; ++n) {
                        const int col0 = u.pn * BM + bj * HALF + wc * 32 + 16 * n + 4 * fq; const f32x4 v = acc[ai][bj][m][n];
                        if (col0 < 1024) { u32x2 w; w.x = cvt_pk_bf16(v[0], v[1]); w.y = cvt_pk_bf16(v[2], v[3]); *(u32x2*)(Km + (size_t)row * 1024 + col0) = w; }
                        else { const int cv = col0 - 1024, head = cv >> 8, d = cv & 255, sq = row >> 8, key = row & 255;
#pragma unroll
                            for (int i = 0; i < 4; ++i) Vt[((size_t)((sq * 4 + head) * 256 + d + i)) * 256 + key] = f2bf(v[i]); }
                    }
            }
    }
};
template <int WHICH> struct EpiY {
    static constexpr bool PERM = true;
    bf16* P;
    DI void operator()(const f32x4 (&acc)[2][2][4][2], const Unit& u, int wr, int wc, int fr, int fq) const {
#pragma unroll
        for (int ai = 0; ai < 2; ++ai)
#pragma unroll
            for (int m = 0; m < 4; ++m) {
                const int row = u.pm * BM + ai * HALF + wr * 64 + m * 16 + fr;
#pragma unroll
                for (int bj = 0; bj < 2; ++bj) {
                    const int col0 = u.pn * BM + bj * HALF + wc * 32 + 8 * fq;
                    bf16* gp = P + OFF_GH + (size_t)row * 1024 + col0;
                    const u32x4 gh = *(const u32x4*)gp;
                    const f32x4 a0 = acc[ai][bj][m][0], a1 = acc[ai][bj][m][1];
                    float o[8];
                    if (WHICH == 1) {
                        o[0] = lo_f(gh.x) * a0[0]; o[1] = hi_f(gh.x) * a0[1]; o[2] = lo_f(gh.y) * a0[2]; o[3] = hi_f(gh.y) * a0[3];
                        o[4] = lo_f(gh.z) * a1[0]; o[5] = hi_f(gh.z) * a1[1]; o[6] = lo_f(gh.w) * a1[2]; o[7] = hi_f(gh.w) * a1[3];
                    } else {
                        const u32x4 ga = *(const u32x4*)(gp + PE1);
                        o[0] = lo_f(gh.x) + lo_f(ga.x) * a0[0]; o[1] = hi_f(gh.x) + hi_f(ga.x) * a0[1]; o[2] = lo_f(gh.y) + lo_f(ga.y) * a0[2]; o[3] = hi_f(gh.y) + hi_f(ga.y) * a0[3];
                        o[4] = lo_f(gh.z) + lo_f(ga.z) * a1[0]; o[5] = hi_f(gh.z) + hi_f(ga.z) * a1[1]; o[6] = lo_f(gh.w) + lo_f(ga.w) * a1[2]; o[7] = hi_f(gh.w) + hi_f(ga.w) * a1[3];
                    }
                    u32x4 w; w.x = cvt_pk_bf16(o[0], o[1]); w.y = cvt_pk_bf16(o[2], o[3]); w.z = cvt_pk_bf16(o[4], o[5]); w.w = cvt_pk_bf16(o[6], o[7]);
                    *(u32x4*)gp = w;
                }
            }
    }
};
template <int MODE> struct EpiRes {
    static constexpr bool PERM = true;
    const float* xin; float* out; bf16* hb16; float* ss;
    DI void operator()(const f32x4 (&acc)[2][2][4][2], const Unit& u, int wr, int wc, int fr, int fq) const {
#pragma unroll
        for (int ai = 0; ai < 2; ++ai)
#pragma unroll
            for (int m = 0; m < 4; ++m) {
                const int row = u.pm * BM + ai * HALF + wr * 64 + m * 16 + fr;
                const size_t off = (size_t)row * DM + u.pn * BM + wc * 32 + 8 * fq;
                float part = 0.f;
#pragma unroll
                for (int bj = 0; bj < 2; ++bj) {
                    f32x4 v0, v1;
                    if (MODE == 0) { v0 = *(const f32x4*)(xin + off + bj * HALF); v1 = *(const f32x4*)(xin + off + bj * HALF + 4); }
                    else { const u32x4 hb = *(const u32x4*)(hb16 + off + bj * HALF); v0 = (f32x4){lo_f(hb.x), hi_f(hb.x), lo_f(hb.y), hi_f(hb.y)}; v1 = (f32x4){lo_f(hb.z), hi_f(hb.z), lo_f(hb.w), hi_f(hb.w)}; }
                    v0 = v0 + acc[ai][bj][m][0]; v1 = v1 + acc[ai][bj][m][1];
                    if (MODE == 2) { *(f32x4*)(out + off + bj * HALF) = v0; *(f32x4*)(out + off + bj * HALF + 4) = v1; }
                    else { u32x4 w; w.x = cvt_pk_bf16(v0[0], v0[1]); w.y = cvt_pk_bf16(v0[2], v0[3]); w.z = cvt_pk_bf16(v1[0], v1[1]); w.w = cvt_pk_bf16(v1[2], v1[3]); *(u32x4*)(hb16 + off + bj * HALF) = w;
                        v0 = (f32x4){lo_f(w.x), hi_f(w.x), lo_f(w.y), hi_f(w.y)}; v1 = (f32x4){lo_f(w.z), hi_f(w.z), lo_f(w.w), hi_f(w.w)}; }
                    part += (v0[0] * v0[0] + v0[1] * v0[1]) + (v0[2] * v0[2] + v0[3] * v0[3]) + (v1[0] * v1[0] + v1[1] * v1[1]) + (v1[2] * v1[2] + v1[3] * v1[3]);
                }
                part += __shfl_xor(part, 16); part += __shfl_xor(part, 32); if (fq == 0) ss[(size_t)row * 16 + u.pn * 4 + wc] = part;
            }
    }
};
template <int ACT> struct EpiBf {
    static constexpr bool PERM = true;
    bf16* O; int ldc; float scale; const float* ss;
    DI void operator()(const f32x4 (&acc)[2][2][4][2], const Unit& u, int wr, int wc, int fr, int fq) const {
#pragma unroll
        for (int ai = 0; ai < 2; ++ai)
#pragma unroll
            for (int m = 0; m < 4; ++m) {
                const int row = u.pm * BM + ai * HALF + wr * 64 + m * 16 + fr;
                bf16* rowp = O + (size_t)row * ldc + u.pn * BM + wc * 32 + 8 * fq;
                float ssum; { const f32x4* sp = (const f32x4*)(ss + (size_t)row * 16); const f32x4 s0 = sp[0], s1 = sp[1], s2 = sp[2], s3 = sp[3];
                    ssum = ((s0[0] + s0[1]) + (s0[2] + s0[3])) + ((s1[0] + s1[1]) + (s1[2] + s1[3])) + ((s2[0] + s2[1]) + (s2[2] + s2[3])) + ((s3[0] + s3[1]) + (s3[2] + s3[3])); }
                const float rstd = rsqrtf(ssum * (1.0f / DM) + RMS_EPS);
                const float sc = (ACT == 1) ? rstd * rstd : rstd * scale;
#pragma unroll
                for (int bj = 0; bj < 2; ++bj) {
                    f32x4 v0 = acc[ai][bj][m][0], v1 = acc[ai][bj][m][1];
                    if (ACT == 1) {
#pragma unroll
                        for (int i = 0; i < 4; ++i) { const float a = fmaxf(v0[i], 0.f), b = fmaxf(v1[i], 0.f); v0[i] = a * a * sc; v1[i] = b * b * sc; }
                    } else { v0 = v0 * sc; v1 = v1 * sc; }
                    u32x4 w; w.x = cvt_pk_bf16(v0[0], v0[1]); w.y = cvt_pk_bf16(v0[2], v0[3]); w.z = cvt_pk_bf16(v1[0], v1[1]); w.w = cvt_pk_bf16(v1[2], v1[3]);
                    *(u32x4*)(rowp + bj * HALF) = w;
                }
            }
    }
};
}

DI void p0_transpose_item(const float* W, int K, int N, bf16* WT, const float* gain, LAS float* scr, int item, int lane) {
    const int nblk = N / 32, kb = item / nblk, nb = item % nblk, k0 = 64 * kb, n0 = 32 * nb;
    float wv[32];
#pragma unroll
    for (int i = 0; i < 32; ++i) { const int kk = 2 * i + (lane >> 5); wv[i] = W[(size_t)(k0 + kk) * N + n0 + (lane & 31)]; }
    if (gain) {
#pragma unroll
        for (int i = 0; i < 32; ++i) wv[i] *= gain[k0 + 2 * i + (lane >> 5)];
    }
#pragma unroll
    for (int i = 0; i < 32; ++i) { const int kk = 2 * i + (lane >> 5); scr[kk * 33 + (lane & 31)] = wv[i]; }
    asm volatile("s_waitcnt lgkmcnt(0)" ::: "memory");
    const int c = lane & 7;
#pragma unroll
    for (int j = 0; j < 4; ++j) { const int n = (lane >> 3) + 8 * j; const LAS float* s = scr + (8 * c) * 33 + n;
        u32x4 o; o.x = pk2(s[0 * 33], s[1 * 33]); o.y = pk2(s[2 * 33], s[3 * 33]); o.z = pk2(s[4 * 33], s[5 * 33]); o.w = pk2(s[6 * 33], s[7 * 33]);
        *(u32x4*)(WT + (size_t)(n0 + n) * K + k0 + 8 * c) = o; }
    asm volatile("s_waitcnt lgkmcnt(0)" ::: "memory");
}
DI void norm_row_bf16(const float* xrow, bf16* orow, int lane) {
    const f32x4* xr = (const f32x4*)xrow + lane;
    f32x4 v[4]; float s = 0.f;
#pragma unroll
    for (int j = 0; j < 4; ++j) { v[j] = xr[64 * j]; s += (v[j].x * v[j].x + v[j].y * v[j].y) + (v[j].z * v[j].z + v[j].w * v[j].w); }
    const float rstd = rsqrtf(wave_sum(s) * (1.f / DM) + RMS_EPS);
    u32x2* o8 = (u32x2*)orow + lane;
#pragma unroll
    for (int j = 0; j < 4; ++j) { u32x2 w; w.x = pk2(v[j].x * rstd, v[j].y * rstd); w.y = pk2(v[j].z * rstd, v[j].w * rstd); o8[64 * j] = w; }
}
DI void final_row_ss(float* hrow, const float* g, const float* ssp, int lane) {
    f32x4* xr = (f32x4*)hrow + lane; const f32x4* gr = (const f32x4*)g + lane;
    const f32x4 s0 = ((const f32x4*)ssp)[0], s1 = ((const f32x4*)ssp)[1], s2 = ((const f32x4*)ssp)[2], s3 = ((const f32x4*)ssp)[3];
    const float ssrow = ((s0[0] + s0[1]) + (s0[2] + s0[3])) + ((s1[0] + s1[1]) + (s1[2] + s1[3])) + ((s2[0] + s2[1]) + (s2[2] + s2[3])) + ((s3[0] + s3[1]) + (s3[2] + s3[3]));
    const float rstd = rsqrtf(ssrow * (1.f / DM) + RMS_EPS);
    f32x4 v[4];
#pragma unroll
    for (int j = 0; j < 4; ++j) v[j] = xr[64 * j];
#pragma unroll
    for (int j = 0; j < 4; ++j) xr[64 * j] = v[j] * rstd * gr[64 * j];
}
DI void final_row(float* hrow, const float* g, int lane) {
    f32x4* xr = (f32x4*)hrow + lane; const f32x4* gr = (const f32x4*)g + lane;
    f32x4 v[4]; float s = 0.f;
#pragma unroll
    for (int j = 0; j < 4; ++j) { v[j] = xr[64 * j]; s += (v[j].x * v[j].x + v[j].y * v[j].y) + (v[j].z * v[j].z + v[j].w * v[j].w); }
    const float rstd = rsqrtf(wave_sum(s) * (1.f / DM) + RMS_EPS);
#pragma unroll
    for (int j = 0; j < 4; ++j) xr[64 * j] = v[j] * rstd * gr[64 * j];
}

constexpr int HG_QD = 0, HG_KD = 17408, HG_QS = 34816, HG_K0E = 52224, HG_KST = 60928, HG_VT = 79360, HG_AM = 97792, HG_TOT = 107008, HG_DL = 109056;
template <int PASS>
DI void hgrn_item(LAS unsigned char* lds, const bf16* Pb, bf16* Of, bf16* Ob, float* segL, float* segD, int item, int tid) {
    const int lane = tid & 63, w = __builtin_amdgcn_readfirstlane(tid >> 6), r16 = lane & 15, q4 = lane >> 4;
    const int sg = item & 7, dir = (item >> 3) & 1, head = (item >> 4) & 7, sq = item >> 7;
    if (PASS == 1 && sg == 7) return;
    const int kcol = tid & 127, qtr = tid >> 7;
    const char* ubq = (const char*)(Pb + OFF_Q + (size_t)sq * SEQ * 1024 + head * 128);
    const char* ubf = (const char*)(Pb + OFF_FF + (size_t)dir * PE1 + (size_t)sq * SEQ * 1024 + head * 128);
    const char* ubv = (const char*)(Pb + OFF_V + (size_t)sq * SEQ * 1024 + head * 128);
    const unsigned voff0 = (unsigned)kcol * 2u + (unsigned)(dir ? 63 - 16 * qtr : 16 * qtr) * 2048u;
    const int vstep = dir ? -2048 : 2048;
    char* uo = (char*)((dir ? Ob : Of) + (size_t)sq * SEQ * DM + head * 128);
    f32x4 S[8];
#pragma unroll
    for (int kt = 0; kt < 8; ++kt) S[kt] = (f32x4){0.f, 0.f, 0.f, 0.f};
    if (PASS == 2) {
        for (int s2 = 0; s2 < sg; ++s2) {
            const int it2 = item - sg + s2;
            const float* Lp = segL + (size_t)it2 * 16384 + (size_t)(w * 8) * 256 + lane;
            const float* Dp = segD + (size_t)it2 * 128 + 4 * q4;
#pragma unroll
            for (int kt = 0; kt < 8; ++kt) { const f32x4 d = *(const f32x4*)(Dp + 16 * kt);
#pragma unroll
                for (int i = 0; i < 4; ++i) S[kt][i] = d[i] * S[kt][i] + Lp[(kt * 4 + i) * 64]; }
        }
    }
    float bseg = 0.f;
    LAS float* TOT = (LAS float*)(lds + HG_TOT); LAS float* DL = (LAS float*)(lds + HG_DL);
    unsigned short qv[16], vv[16], lfn[16];
#define HG_LOAD(pp) do { const size_t cb_ = (size_t)(dir ? (SEQ - 64 * ((pp) + 1)) : (64 * (pp))) * 2048;     \
        const char* cq_ = ubq + cb_; const char* cf_ = ubf + cb_; const char* cv_ = ubv + cb_; \
        _Pragma("unroll") for (int i = 0; i < 16; ++i) { const unsigned vo_ = voff0 + (unsigned)(vstep * i); \
            lfn[i] = *(const bf16*)(cf_ + vo_); vv[i] = *(const bf16*)(cv_ + vo_); if (PASS == 2) qv[i] = *(const bf16*)(cq_ + vo_); } } while (0)
    HG_LOAD(sg * 16);
    for (int j = 0; j < 16; ++j) {
        const int p = sg * 16 + j;
        float cs[16]; unsigned short lfr[16];
#pragma unroll
        for (int i = 0; i < 16; ++i) lfr[i] = lfn[i];
        { float run = 0.f;
#pragma unroll
          for (int i = 0; i < 16; ++i) { run += bf2f(lfr[i]); cs[i] = run; } }
        TOT[qtr * 128 + kcol] = cs[15];
        { u32x4 a, b; a.x = vv[0] | ((unsigned)vv[1] << 16); a.y = vv[2] | ((unsigned)vv[3] << 16); a.z = vv[4] | ((unsigned)vv[5] << 16); a.w = vv[6] | ((unsigned)vv[7] << 16);
          b.x = vv[8] | ((unsigned)vv[9] << 16); b.y = vv[10] | ((unsigned)vv[11] << 16); b.z = vv[12] | ((unsigned)vv[13] << 16); b.w = vv[14] | ((unsigned)vv[15] << 16);
          LAS u32x4* vp = (LAS u32x4*)(lds + HG_VT + kcol * 144 + qtr * 32); vp[0] = a; vp[1] = b; }
        __syncthreads();
        const float t0 = TOT[kcol], t1 = TOT[128 + kcol], t2 = TOT[256 + kcol], t3 = TOT[384 + kcol];
        const float off = (qtr > 0 ? t0 : 0.f) + (qtr > 1 ? t1 : 0.f) + (qtr > 2 ? t2 : 0.f);
        const float r1 = t0 + t1, blast = (t0 + t1) + (t2 + t3);
        const float rblk = (qtr >= 2) ? r1 : 0.f;
        if (qtr == 0) { DL[kcol] = ex2(blast * 1.4426950408889634f); bseg += blast; }
        unsigned ks[8];
        constexpr float L2E = 1.4426950408889634f;
        const float er1 = ex2(r1 * L2E), ebl1 = ex2((blast - r1) * L2E);
#pragma unroll
        for (int i = 0; i < 16; i += 2) {
            float kk[2], bb[2], e1[2], e2[2], eks[2], e3[2];
#pragma unroll
            for (int e = 0; e < 2; ++e) {
                bb[e] = off + cs[i + e]; kk[e] = 1.0f - ex2(bf2f(lfr[i + e]) * L2E);
                if (qtr < 2) {
                    e1[e] = ex2(bb[e] * L2E); e2[e] = ex2(fminf(-bb[e], 80.f) * L2E); e3[e] = ex2((r1 - bb[e]) * L2E); eks[e] = e3[e] * ebl1;
                } else {
                    e1[e] = ex2((bb[e] - r1) * L2E); e2[e] = ex2(fminf(r1 - bb[e], 80.f) * L2E); e3[e] = 0.f; eks[e] = ex2((blast - bb[e]) * L2E);
                }
            }
            ks[i >> 1] = cvtpk(kk[0] * eks[0], kk[1] * eks[1]);
            if (PASS == 2) {
                const float q0 = bf2f(qv[i]), q1 = bf2f(qv[i + 1]);
                const int tau = 16 * qtr + i;
                const unsigned wqd = cvtpk(q0 * e1[0], q1 * e1[1]);
                const unsigned wkd = cvtpk(kk[0] * e2[0], kk[1] * e2[1]);
                const unsigned wqs = (qtr < 2) ? wqd : cvtpk(q0 * e1[0] * er1, q1 * e1[1] * er1);
                *(LAS bf16*)(lds + HG_QD + tau * 272 + kcol * 2) = (bf16)(wqd & 0xffffu); *(LAS bf16*)(lds + HG_QD + (tau + 1) * 272 + kcol * 2) = (bf16)(wqd >> 16);
                *(LAS bf16*)(lds + HG_KD + tau * 272 + kcol * 2) = (bf16)(wkd & 0xffffu); *(LAS bf16*)(lds + HG_KD + (tau + 1) * 272 + kcol * 2) = (bf16)(wkd >> 16);
                *(LAS bf16*)(lds + HG_QS + tau * 272 + kcol * 2) = (bf16)(wqs & 0xffffu); *(LAS bf16*)(lds + HG_QS + (tau + 1) * 272 + kcol * 2) = (bf16)(wqs >> 16);
                if (qtr < 2) { const unsigned wk0 = cvtpk(kk[0] * e3[0], kk[1] * e3[1]);
                    *(LAS bf16*)(lds + HG_K0E + tau * 272 + kcol * 2) = (bf16)(wk0 & 0xffffu); *(LAS bf16*)(lds + HG_K0E + (tau + 1) * 272 + kcol * 2) = (bf16)(wk0 >> 16); }
            }
        }
        { LAS u32x4* kp = (LAS u32x4*)(lds + HG_KST + kcol * 144 + qtr * 32); kp[0] = (u32x4){ks[0], ks[1], ks[2], ks[3]}; kp[1] = (u32x4){ks[4], ks[5], ks[6], ks[7]}; }
        __syncthreads();
        if (j + 1 < 16) HG_LOAD(p + 1);
        if (PASS == 2) {
            const int ti = w >> 1;
#pragma unroll
            for (int e = 0; e < 2; ++e) {
                const int sj = 2 * (w & 1) + e;
                f32x4 a4 = (f32x4){0.f, 0.f, 0.f, 0.f};
                if (sj <= ti) {
                    const int bsrc = (ti >= 2 && sj < 2) ? HG_K0E : HG_KD;
                    bf16x8 fa[4], fb[4];
#pragma unroll
                    for (int st = 0; st < 4; ++st) {
                        fa[st] = *(const LAS bf16x8*)(lds + HG_QD + (16 * ti + r16) * 272 + (32 * st + 8 * q4) * 2);
                        fb[st] = *(const LAS bf16x8*)(lds + bsrc + (16 * sj + r16) * 272 + (32 * st + 8 * q4) * 2);
                    }
                    __builtin_amdgcn_sched_barrier(0);
#pragma unroll
                    for (int st = 0; st < 4; ++st) a4 = MFMA16(fa[st], fb[st], a4);
                    __builtin_amdgcn_sched_barrier(0);
                }
#pragma unroll
                for (int i = 0; i < 4; ++i) { const int t = 16 * ti + 4 * q4 + i, s = 16 * sj + r16; *(LAS bf16*)(lds + HG_AM + t * 144 + s * 2) = f2bf(s <= t ? a4[i] : 0.f); }
            }
            __syncthreads();
        }
        bf16x8 bv[2];
#pragma unroll
        for (int st = 0; st < 2; ++st) bv[st] = *(const LAS bf16x8*)(lds + HG_VT + (16 * w + r16) * 144 + (32 * st + 8 * q4) * 2);
        if (PASS == 2) {
            bf16x8 sb[4];
#pragma unroll
            for (int k2 = 0; k2 < 4; ++k2) { u32x4 pz; pz.x = pk2(S[2 * k2][0], S[2 * k2][1]); pz.y = pk2(S[2 * k2][2], S[2 * k2][3]); pz.z = pk2(S[2 * k2 + 1][0], S[2 * k2 + 1][1]); pz.w = pk2(S[2 * k2 + 1][2], S[2 * k2 + 1][3]);
                sb[k2] = __builtin_bit_cast(bf16x8, pz); }
#pragma unroll
            for (int ti = 0; ti < 4; ++ti) {
                f32x4 o4 = (f32x4){0.f, 0.f, 0.f, 0.f};
                bf16x8 fam[2]; s16x4 ql[4], qh[4];
#pragma unroll
                for (int st = 0; st < 2; ++st) fam[st] = *(const LAS bf16x8*)(lds + HG_AM + (16 * ti + r16) * 144 + (32 * st + 8 * q4) * 2);
#pragma unroll
                for (int k2 = 0; k2 < 4; ++k2) {
                    ql[k2] = *(const LAS s16x4*)(lds + HG_QS + (16 * ti + r16) * 272 + (32 * k2 + 4 * q4) * 2);
                    qh[k2] = *(const LAS s16x4*)(lds + HG_QS + (16 * ti + r16) * 272 + (32 * k2 + 16 + 4 * q4) * 2);
                }
                __builtin_amdgcn_sched_barrier(0);
#pragma unroll
                for (int st = 0; st < 2; ++st) o4 = MFMA16(bv[st], fam[st], o4);
#pragma unroll
                for (int k2 = 0; k2 < 4; ++k2) o4 = MFMA16(sb[k2], __builtin_shufflevector(ql[k2], qh[k2], 0, 1, 2, 3, 4, 5, 6, 7), o4);
                __builtin_amdgcn_sched_barrier(0);
{ const size_t cbo = (size_t)(dir ? (SEQ - 64 * (p + 1)) : (64 * p)) * 2048;
                  const unsigned vo = (unsigned)(16 * w + 4 * q4) * 2u + (unsigned)(dir ? 63 - (16 * ti + r16) : (16 * ti + r16)) * 2048u;
                  u32x2 wv; wv.x = pk2(o4[0], o4[1]); wv.y = pk2(o4[2], o4[3]); *(u32x2*)(uo + cbo + vo) = wv; }
            }
        }
#pragma unroll
        for (int kh = 0; kh < 2; ++kh) {
            bf16x8 fk[4][2]; f32x4 dd[4];
#pragma unroll
            for (int k4 = 0; k4 < 4; ++k4) { const int kt = 4 * kh + k4;
                dd[k4] = *(const LAS f32x4*)(lds + HG_DL + (16 * kt + 4 * q4) * 4);
#pragma unroll
                for (int st = 0; st < 2; ++st) fk[k4][st] = *(const LAS bf16x8*)(lds + HG_KST + (16 * kt + r16) * 144 + (32 * st + 8 * q4) * 2); }
            __builtin_amdgcn_sched_barrier(0);
#pragma unroll
            for (int k4 = 0; k4 < 4; ++k4) { const int kt = 4 * kh + k4; S[kt] = S[kt] * dd[k4]; }
#pragma unroll
            for (int st = 0; st < 2; ++st)
#pragma unroll
                for (int k4 = 0; k4 < 4; ++k4) { const int kt = 4 * kh + k4; S[kt] = MFMA16(fk[k4][st], bv[st], S[kt]); }
            __builtin_amdgcn_sched_barrier(0);
        }
        __syncthreads();
    }
    if (PASS == 1) {
        float* Lp = segL + (size_t)item * 16384 + (size_t)(w * 8) * 256 + lane;
#pragma unroll
        for (int kt = 0; kt < 8; ++kt)
#pragma unroll
            for (int i = 0; i < 4; ++i) Lp[(kt * 4 + i) * 64] = S[kt][i];
        if (qtr == 0) segD[(size_t)item * 128 + kcol] = __expf(bseg);
    }
}

constexpr int DA_K = 0, DA_V = 69632;
typedef short v4i16_t __attribute__((ext_vector_type(4)));
DI s16x4 vtr(LAS unsigned char* p) { return __builtin_bit_cast(s16x4, __builtin_amdgcn_ds_read_tr16_b64_v4i16((LAS v4i16_t*)p)); }
struct DaIdx { int head, g, sq, dil, L, res, m0, qcol; };
DI DaIdx da_index(int item) {
    DaIdx d; const int idx = item & 63; d.head = (item >> 6) & 3; d.g = (item >> 8) % 3; d.sq = (item >> 8) / 3;
    d.dil = (d.g == 0) ? 1 : ((d.g == 1) ? 4 : 16); d.L = SEQ / d.dil; const int tpr = d.L / 128; d.res = idx / tpr; d.m0 = 128 * (idx % tpr);
    d.qcol = 128 * d.head; return d;
}
DI void da_load(const bf16* Pb, int item, int tid, u32x4 (&kreg)[8], u32x4 (&vreg)[8], bf16x8 (&qf)[4]) {
    const DaIdx d = da_index(item);
    const int lane = tid & 63, w = tid >> 6, r16 = lane & 15, q4 = lane >> 4;
    const bf16* rowbase = Pb + OFF_ATT0 + (size_t)(3 * d.g) * PE2 + (size_t)d.sq * SEQ * 512;
    const bf16* qrow = rowbase + (size_t)((d.m0 + 16 * w + r16) * d.dil + d.res) * 512 + d.qcol;
#pragma unroll
    for (int st = 0; st < 4; ++st) qf[st] = *(const bf16x8*)(qrow + 32 * st + 8 * q4);
#pragma unroll
    for (int it = 0; it < 8; ++it) {
        const int e = it * 512 + tid, key = e >> 4, ch = e & 15, m = d.m0 - 64 + key;
        kreg[it] = (u32x4){0u, 0u, 0u, 0u}; vreg[it] = kreg[it];
        if (m >= 0 && m < d.L) { const bf16* rp = rowbase + (size_t)(m * d.dil + d.res) * 512 + d.qcol + ch * 8; kreg[it] = *(const u32x4*)(rp + PE2); vreg[it] = *(const u32x4*)(rp + 2 * PE2); }
    }
}
DI void dattn_items(LAS unsigned char* lds, bf16* Pb, float* lse, int first, int stride, int nitems, int tid) {
    const int lane = tid & 63, w = __builtin_amdgcn_readfirstlane(tid >> 6), r16 = lane & 15, q4 = lane >> 4;
    u32x4 kreg[8], vreg[8]; bf16x8 qn[4];
    if (first < nitems) da_load(Pb, first, tid, kreg, vreg, qn);
    for (int item = first; item < nitems; item += stride) {
    const DaIdx d = da_index(item);
    const int head = d.head, g = d.g, sq = d.sq, dil = d.dil, L = d.L, res = d.res, m0 = d.m0, qcol = d.qcol;
    bf16* rowbase = Pb + OFF_ATT0 + (size_t)(3 * g) * PE2 + (size_t)sq * SEQ * 512;
    const int mq = m0 + 16 * w + r16;
    bf16* qrow = rowbase + (size_t)(mq * dil + res) * 512 + qcol;
    bf16x8 qf[4];
#pragma unroll
    for (int st = 0; st < 4; ++st) qf[st] = qn[st];
#pragma unroll
    for (int it = 0; it < 8; ++it) {
        const int e = it * 512 + tid, key = e >> 4, ch = e & 15;
        *(LAS u32x4*)(lds + DA_K + key * 272 + ch * 16) = kreg[it];
        *(LAS u32x4*)(lds + DA_V + key * 288 + ch * 16) = vreg[it];
    }
    __syncthreads();
    if (item + stride < nitems) da_load(Pb, item + stride, tid, kreg, vreg, qn);
    f32x4 sc[9];
    float mx = -1e30f;
#pragma unroll
    for (int kt = 0; kt < 9; ++kt) {
        f32x4 a4 = (f32x4){0.f, 0.f, 0.f, 0.f};
        bf16x8 fa[4];
#pragma unroll
        for (int st = 0; st < 4; ++st) fa[st] = *(const LAS bf16x8*)(lds + DA_K + (16 * w + 16 * kt + r16) * 272 + (32 * st + 8 * q4) * 2);
        __builtin_amdgcn_sched_barrier(0);
#pragma unroll
        for (int st = 0; st < 4; ++st) a4 = MFMA16(fa[st], qf[st], a4);
        __builtin_amdgcn_sched_barrier(0);
#pragma unroll
        for (int i = 0; i < 4; ++i) { const int mk = m0 - 64 + 16 * w + 16 * kt + 4 * q4 + i; const int dd = mk - mq;
            const bool ok = (mk >= 0) && (mk < L) && (dd <= 64) && (dd >= -64); a4[i] = ok ? a4[i] : -1e30f; mx = fmaxf(mx, a4[i]); }
        sc[kt] = a4;
    }
    mx = fmaxf(mx, __shfl_xor(mx, 16)); mx = fmaxf(mx, __shfl_xor(mx, 32));
    float sum = 0.f;
#pragma unroll
    for (int kt = 0; kt < 9; ++kt)
#pragma unroll
        for (int i = 0; i < 4; ++i) { const float pv = __builtin_amdgcn_exp2f(sc[kt][i] - mx); sc[kt][i] = pv; sum += pv; }
    sum += __shfl_xor(sum, 16); sum += __shfl_xor(sum, 32);
    bf16x8 pb[5];
#pragma unroll
    for (int pp = 0; pp < 5; ++pp) { u32x4 pz; pz.x = pk2(sc[2 * pp][0], sc[2 * pp][1]); pz.y = pk2(sc[2 * pp][2], sc[2 * pp][3]);
        if (pp < 4) { pz.z = pk2(sc[2 * pp + 1][0], sc[2 * pp + 1][1]); pz.w = pk2(sc[2 * pp + 1][2], sc[2 * pp + 1][3]); } else { pz.z = 0u; pz.w = 0u; }
        pb[pp] = __builtin_bit_cast(bf16x8, pz); }
    const float rs = 1.0f / sum;
#pragma unroll
    for (int dt = 0; dt < 8; ++dt) {
        f32x4 o4 = (f32x4){0.f, 0.f, 0.f, 0.f};
        s16x4 vl[5], vh[5];
#pragma unroll
        for (int pp = 0; pp < 5; ++pp) {
            LAS unsigned char* vb = lds + DA_V + (16 * w + 32 * pp + 4 * q4 + (r16 >> 2)) * 288 + (16 * dt + 4 * (r16 & 3)) * 2;
            vl[pp] = vtr(vb);
            vh[pp] = vtr(pp < 4 ? vb + 16 * 288 : vb);
        }
        __builtin_amdgcn_sched_barrier(0);
#pragma unroll
        for (int pp = 0; pp < 5; ++pp) o4 = MFMA16(__builtin_shufflevector(vl[pp], vh[pp], 0, 1, 2, 3, 4, 5, 6, 7), pb[pp], o4);
        __builtin_amdgcn_sched_barrier(0);
        u32x2 wv; wv.x = pk2(o4[0] * rs, o4[1] * rs); wv.y = pk2(o4[2] * rs, o4[3] * rs);
        *(u32x2*)(qrow + 16 * dt + 4 * q4) = wv;
    }
    if (q4 == 0) lse[((size_t)sq * SEQ + (size_t)(mq * dil + res)) * 12 + g * 4 + head] = mx + __builtin_amdgcn_logf(sum);
    __syncthreads();
    }
}

DI void xattn_item(LAS unsigned char* lds, bf16* Qx, const bf16* Kmem, const bf16* Vtmem, int b, int item, int tid) {
    const int lane = tid & 63, w = __builtin_amdgcn_readfirstlane(tid >> 6), r16 = lane & 15, q4 = lane >> 4;
    const int qt = item & 63, head = (item >> 6) & 3, sq = item >> 8, mseq = 2 * b + sq;
    const bf16* Kg = Kmem + (size_t)mseq * 256 * 1024 + head * 256;
    const bf16* Vg = Vtmem + (size_t)(mseq * 4 + head) * 256 * 256;
    bf16* qrow = Qx + ((size_t)sq * SEQ + 128 * qt + 16 * w + r16) * DM + head * 256;
    bf16x8 qf[8];
#pragma unroll
    for (int st = 0; st < 8; ++st) qf[st] = *(const bf16x8*)(qrow + 32 * st + 8 * q4);
    {
        u32x4 kreg[16];
#pragma unroll
        for (int it = 0; it < 16; ++it) { const int e = it * 512 + tid, key = e >> 5, ch = e & 31; kreg[it] = *(const u32x4*)(Kg + (size_t)key * 1024 + ch * 8); }
#pragma unroll
        for (int it = 0; it < 16; ++it) { const int e = it * 512 + tid, key = e >> 5, ch = e & 31; *(LAS u32x4*)(lds + key * 528 + ch * 16) = kreg[it]; }
    }
    __syncthreads();
    f32x4 sc[16]; float mx = -1e30f;
#define XA_KREAD(dst, kt_) _Pragma("unroll") for (int st = 0; st < 8; ++st) dst[st] = *(const LAS bf16x8*)(lds + (16 * (kt_) + r16) * 528 + (32 * st + 8 * q4) * 2)
#define XA_TILE(src, kt_) do { f32x4 a4 = (f32x4){0.f, 0.f, 0.f, 0.f}; _Pragma("unroll") for (int st = 0; st < 8; ++st) a4 = MFMA16(src[st], qf[st], a4); \
        _Pragma("unroll") for (int i = 0; i < 4; ++i) mx = fmaxf(mx, a4[i]); sc[kt_] = a4; } while (0)
    {
#pragma unroll
        for (int kt = 0; kt < 16; ++kt) {
            bf16x8 fa[8];
            XA_KREAD(fa, kt); __builtin_amdgcn_sched_barrier(0);
            XA_TILE(fa, kt); __builtin_amdgcn_sched_barrier(0);
        }
    }
    mx = fmaxf(mx, __shfl_xor(mx, 16)); mx = fmaxf(mx, __shfl_xor(mx, 32));
    float sum = 0.f;
#pragma unroll
    for (int kt = 0; kt < 16; ++kt)
#pragma unroll
        for (int i = 0; i < 4; ++i) { const float pv = __builtin_amdgcn_exp2f(sc[kt][i] - mx); sc[kt][i] = pv; sum += pv; }
    sum += __shfl_xor(sum, 16); sum += __shfl_xor(sum, 32);
    bf16x8 pb[8];
#pragma unroll
    for (int pp = 0; pp < 8; ++pp) { u32x4 pz; pz.x = pk2(sc[2 * pp][0], sc[2 * pp][1]); pz.y = pk2(sc[2 * pp][2], sc[2 * pp][3]); pz.z = pk2(sc[2 * pp + 1][0], sc[2 * pp + 1][1]); pz.w = pk2(sc[2 * pp + 1][2], sc[2 * pp + 1][3]);
        pb[pp] = __builtin_bit_cast(bf16x8, pz); }
    {
        u32x4 vreg[16];
#pragma unroll
        for (int it = 0; it < 16; ++it) { const int e = it * 512 + tid, d = e >> 5, ch = e & 31; vreg[it] = *(const u32x4*)(Vg + (size_t)d * 256 + ch * 8); }
        __syncthreads();
#pragma unroll
        for (int it = 0; it < 16; ++it) { const int e = it * 512 + tid, d = e >> 5, ch = e & 31; *(LAS u32x4*)(lds + d * 528 + ch * 16) = vreg[it]; }
    }
    __syncthreads();
    const float rs = __builtin_amdgcn_rcpf(sum);
#define XA_VREAD(dst, dt_) _Pragma("unroll") for (int pp = 0; pp < 8; ++pp) { dst[2 * pp] = *(const LAS s16x4*)(lds + (16 * (dt_) + r16) * 528 + (32 * pp + 4 * q4) * 2); \
        dst[2 * pp + 1] = *(const LAS s16x4*)(lds + (16 * (dt_) + r16) * 528 + (32 * pp + 16 + 4 * q4) * 2); }
#define XA_OTILE(src, dt_) do { f32x4 o4 = (f32x4){0.f, 0.f, 0.f, 0.f}; _Pragma("unroll") for (int pp = 0; pp < 8; ++pp) o4 = MFMA16(__builtin_shufflevector(src[2 * pp], src[2 * pp + 1], 0, 1, 2, 3, 4, 5, 6, 7), pb[pp], o4); \
        u32x2 wv; wv.x = cvtpk(o4[0] * rs, o4[1] * rs); wv.y = cvtpk(o4[2] * rs, o4[3] * rs); *(u32x2*)(qrow + 16 * (dt_) + 4 * q4) = wv; } while (0)
    {
#pragma unroll
        for (int dt = 0; dt < 16; ++dt) {
            s16x4 va[16];
            XA_VREAD(va, dt); __builtin_amdgcn_sched_barrier(0);
            XA_OTILE(va, dt); __builtin_amdgcn_sched_barrier(0);
        }
    }
    __syncthreads();
}

DI void post_row(bf16* P, int m, const bf16* ofr, const bf16* obr, const float* lser, const float* gn, bf16* Urow, int lane) {
    bf16* arow = P + OFF_ATT0 + (size_t)m * 512 + 8 * lane; const bf16* grow = P + OFF_G + (size_t)m * 1024;
    { const int h = lane >> 4; const float l0 = lser[h], l1 = lser[4 + h], l2 = lser[8 + h]; const float mxl = fmaxf(l0, fmaxf(l1, l2));
      float w0 = __builtin_amdgcn_exp2f(l0 - mxl), w1 = __builtin_amdgcn_exp2f(l1 - mxl), w2 = __builtin_amdgcn_exp2f(l2 - mxl); const float rs = 1.0f / (w0 + w1 + w2); w0 *= rs; w1 *= rs; w2 *= rs;
      const u32x4 a = *(const u32x4*)arow, b = *(const u32x4*)(arow + 3 * PE2), c = *(const u32x4*)(arow + 6 * PE2);
      u32x4 o;
      o.x = pk2(w0 * lo_f(a.x) + w1 * lo_f(b.x) + w2 * lo_f(c.x), w0 * hi_f(a.x) + w1 * hi_f(b.x) + w2 * hi_f(c.x));
      o.y = pk2(w0 * lo_f(a.y) + w1 * lo_f(b.y) + w2 * lo_f(c.y), w0 * hi_f(a.y) + w1 * hi_f(b.y) + w2 * hi_f(c.y));
      o.z = pk2(w0 * lo_f(a.z) + w1 * lo_f(b.z) + w2 * lo_f(c.z), w0 * hi_f(a.z) + w1 * hi_f(b.z) + w2 * hi_f(c.z));
      o.w = pk2(w0 * lo_f(a.w) + w1 * lo_f(b.w) + w2 * lo_f(c.w), w0 * hi_f(a.w) + w1 * hi_f(b.w) + w2 * hi_f(c.w));
      *(u32x4*)arow = o; }
    { float o[16];
#pragma unroll
      for (int hlf = 0; hlf < 2; ++hlf) { const u32x4 a = *(const u32x4*)(ofr + 16 * lane + 8 * hlf), b = *(const u32x4*)(obr + 16 * lane + 8 * hlf);
          o[8 * hlf + 0] = lo_f(a.x) + lo_f(b.x); o[8 * hlf + 1] = hi_f(a.x) + hi_f(b.x); o[8 * hlf + 2] = lo_f(a.y) + lo_f(b.y); o[8 * hlf + 3] = hi_f(a.y) + hi_f(b.y);
          o[8 * hlf + 4] = lo_f(a.z) + lo_f(b.z); o[8 * hlf + 5] = hi_f(a.z) + hi_f(b.z); o[8 * hlf + 6] = lo_f(a.w) + lo_f(b.w); o[8 * hlf + 7] = hi_f(a.w) + hi_f(b.w); }
      float ss = 0.f;
#pragma unroll
      for (int i = 0; i < 16; ++i) ss += o[i] * o[i];
      ss += __shfl_xor(ss, 1); ss += __shfl_xor(ss, 2); ss += __shfl_xor(ss, 4);
      const float rstd = rsqrtf(ss * (1.0f / 128.0f) + RMS_EPS);
      const int vc = (16 * lane) & 127;
#pragma unroll
      for (int hlf = 0; hlf < 2; ++hlf) { const u32x4 gsl = *(const u32x4*)(grow + 16 * lane + 8 * hlf);
          const f32x4 g0 = *(const f32x4*)(gn + vc + 8 * hlf), g1 = *(const f32x4*)(gn + vc + 8 * hlf + 4);
          u32x4 wv;
          wv.x = pk2(o[8 * hlf + 0] * rstd * g0[0] * lo_f(gsl.x), o[8 * hlf + 1] * rstd * g0[1] * hi_f(gsl.x));
          wv.y = pk2(o[8 * hlf + 2] * rstd * g0[2] * lo_f(gsl.y), o[8 * hlf + 3] * rstd * g0[3] * hi_f(gsl.y));
          wv.z = pk2(o[8 * hlf + 4] * rstd * g1[0] * lo_f(gsl.z), o[8 * hlf + 5] * rstd * g1[1] * hi_f(gsl.z));
          wv.w = pk2(o[8 * hlf + 6] * rstd * g1[2] * lo_f(gsl.w), o[8 * hlf + 7] * rstd * g1[3] * hi_f(gsl.w));
          *(u32x4*)(Urow + 16 * lane + 8 * hlf) = wv; } }
}

#define XB_TMO      128
#define XB_XCNT(j)  (256  + 64 * (j))
#define XB_XSUB(j)  (1280 + 64 * (j))
#define XB_XGEN(j)  (2304 + 64 * (j))
#define XB_TOP      3328
#define XB_TOPGEN   3392
#define XCD_BAR_WORDS 3456
#define XB_SPIN_CAP (1u << 18)
DI unsigned xb_ld(unsigned* p)              { return __hip_atomic_load(p, __ATOMIC_RELAXED, __HIP_MEMORY_SCOPE_AGENT); }
DI unsigned xb_add(unsigned* p, unsigned v) { return __hip_atomic_fetch_add(p, v, __ATOMIC_RELAXED, __HIP_MEMORY_SCOPE_AGENT); }
DI unsigned xb_xcc_id() { return (unsigned)__builtin_amdgcn_s_getreg((3 << 11) | 20) & 0xFu; }
#define XB_SPIN(cond, bar) do { unsigned _sp = 0; while (cond) { __builtin_amdgcn_s_sleep(1); \
    if ((++_sp & 255u) == 0u) { if (xb_ld(&(bar)[XB_TMO])) break; if (_sp > XB_SPIN_CAP) { atomicAdd(&(bar)[XB_TMO], 1u); break; } } } } while (0)
struct XcdBarrier { unsigned* bar; unsigned x; volatile LAS unsigned* st; };
DI XcdBarrier xcd_barrier_post(unsigned* bar, volatile LAS unsigned* st) {
    XcdBarrier b; b.bar = bar; b.x = xb_xcc_id(); b.st = st;
    if (threadIdx.x == 0) (void)xb_add(&bar[XB_XCNT(b.x)], 1u);
    return b;
}
DI void xcd_barrier_complete(unsigned* bar, unsigned x, unsigned& nloc, unsigned& nx) {
    const unsigned G = gridDim.x * gridDim.y * gridDim.z;
    unsigned sum, cnt, mine, sp = 0u;
    for (;;) {
        sum = 0u; cnt = 0u; mine = 0u;
#pragma unroll
        for (unsigned j = 0; j < 16; ++j) { const unsigned c = xb_ld(&bar[XB_XCNT(j)]); sum += c; cnt += (c > 0u) ? 1u : 0u; mine = (j == x) ? c : mine; }
        if (sum == G) break;
        __builtin_amdgcn_s_sleep(1);
        if ((++sp & 255u) == 0u) { if (xb_ld(&bar[XB_TMO])) break; if (sp > XB_SPIN_CAP) { atomicAdd(&bar[XB_TMO], 1u); break; } }
    }
    nloc = mine > 0u ? mine : 1u; nx = cnt > 0u ? cnt : 1u;
}
DI void xcd_barrier(const XcdBarrier& b) {
    asm volatile("s_waitcnt vmcnt(0)" ::: "memory");
    __syncthreads();
    if (threadIdx.x == 0) {
        unsigned* bar = b.bar;
        __builtin_amdgcn_s_waitcnt(0);
        unsigned nloc = b.st[0], nx = b.st[1];
        if (nloc == 0u) { xcd_barrier_complete(bar, b.x, nloc, nx); b.st[0] = nloc; b.st[1] = nx; }
        const unsigned old = xb_add(&bar[XB_XSUB(b.x)], 1u);
        const unsigned gen = old / nloc;
        if (old + 1u == (gen + 1u) * nloc) {
            __builtin_amdgcn_fence(__ATOMIC_RELEASE, "agent");
            asm volatile("s_waitcnt vmcnt(0)" ::: "memory");
            const unsigned og = xb_add(&bar[XB_TOP], 1u);
            const unsigned tg = og / nx;
            if (og + 1u == (tg + 1u) * nx) xb_add(&bar[XB_TOPGEN], 1u);
            else XB_SPIN(xb_ld(&bar[XB_TOPGEN]) == tg, bar);
            __builtin_amdgcn_fence(__ATOMIC_ACQUIRE, "agent");
            xb_add(&bar[XB_XGEN(b.x)], 1u);
            asm volatile("s_waitcnt vmcnt(0)" ::: "memory");
        } else {
            XB_SPIN(xb_ld(&bar[XB_XGEN(b.x)]) == gen, bar);
            __builtin_amdgcn_fence(__ATOMIC_ACQUIRE, "agent");
            asm volatile("s_waitcnt vmcnt(0)" ::: "memory");
        }
    }
    __syncthreads();
}

struct Args { const float* in[20]; float* out; unsigned char* ws; int ph_lo, ph_hi; };
constexpr int NPB = 12;
constexpr int NPH = 1 + NBATCH * NPB;

__global__ void __launch_bounds__(512, 2) fwd_kernel(Args args) {
    extern __shared__ __attribute__((aligned(16))) unsigned char lds_raw[];
    LAS unsigned char* lds = (LAS unsigned char*)lds_raw;
    const int G = gridDim.x, bx = blockIdx.x;
    const int NGW = G * 8;
    const int wave = __builtin_amdgcn_readfirstlane((int)threadIdx.x >> 6), gw = bx * 8 + wave;
    unsigned char* ws = args.ws;
    const float* x_prompt = args.in[0]; const float* x_sample = args.in[1];
    bf16* W_in = (bf16*)(ws + WS_WIN); bf16* W_ho = (bf16*)(ws + WS_WHO); bf16* W_ao = (bf16*)(ws + WS_WAO); bf16* W_out = (bf16*)(ws + WS_WOUT);
    bf16* W_xq = (bf16*)(ws + WS_WXQ); bf16* W_xkv = (bf16*)(ws + WS_WXKV); bf16* W_xo = (bf16*)(ws + WS_WXO); bf16* W_f1 = (bf16*)(ws + WS_WF1); bf16* W_f2 = (bf16*)(ws + WS_WF2);
    float* LB = (float*)(ws + WS_LB); float* ROPE = (float*)(ws + WS_ROPE); float* SEGD = (float*)(ws + WS_SEGD); float* SEGL = (float*)(ws + WS_SEGL);
    bf16* MEMN = (bf16*)(ws + WS_MEMN); bf16* KMEM = (bf16*)(ws + WS_KMEM); bf16* VTMEM = (bf16*)(ws + WS_VTMEM); float* LSE = (float*)(ws + WS_LSE);
    bf16* U = (bf16*)(ws + WS_U); bf16* P = (bf16*)(ws + WS_P); float* SS = (float*)(ws + WS_SS);
    cg::grid_group grid = cg::this_grid();
    if (threadIdx.x < 2) *(volatile LAS unsigned*)(lds + LDS_BARST + 4 * threadIdx.x) = 0u;
    __syncthreads();
    XcdBarrier xbar = xcd_barrier_post((unsigned*)(ws + WS_CTL), (volatile LAS unsigned*)(lds + LDS_BARST));

    for (int ph = args.ph_lo; ph < args.ph_hi; ++ph) {
#define TID_INIT unsigned ones_ = ~0u; asm volatile("" : "+s"(ones_)); int tid = wave * 64 + (int)__builtin_amdgcn_mbcnt_hi(ones_, __builtin_amdgcn_mbcnt_lo(ones_, 0u)); asm volatile("" : "+v"(tid)); const int lane = tid & 63; (void)lane;
        if (ph == 0) {
            TID_INIT
            LAS float* scr = (LAS float*)(lds + wave * 16384);
            constexpr int I_IN = 16 * (NIN / 32), I_HO = 16 * 32, I_AO = 8 * 32, I_OUT = 16 * 32, I_XQ = 16 * 32, I_XKV = 16 * 64, I_XO = 16 * 32, I_F1 = 16 * 128, I_F2 = 64 * 32;
            constexpr int NITEMS = I_IN + I_HO + I_AO + I_OUT + I_XQ + I_XKV + I_XO + I_F1 + I_F2;
            for (int it = gw; it < NITEMS; it += NGW) {
                int r = it;
                if (r < I_IN) { p0_transpose_item(args.in[5], 1024, NIN, W_in, args.in[4], scr, r, lane); continue; } r -= I_IN;
                if (r < I_HO) { p0_transpose_item(args.in[8], 1024, 1024, W_ho, nullptr, scr, r, lane); continue; } r -= I_HO;
                if (r < I_AO) { p0_transpose_item(args.in[9], 512, 1024, W_ao, nullptr, scr, r, lane); continue; } r -= I_AO;
                if (r < I_OUT) { p0_transpose_item(args.in[10], 1024, 1024, W_out, nullptr, scr, r, lane); continue; } r -= I_OUT;
                if (r < I_XQ) { p0_transpose_item(args.in[13], 1024, 1024, W_xq, args.in[11], scr, r, lane); continue; } r -= I_XQ;
                if (r < I_XKV) { p0_transpose_item(args.in[14], 1024, 2048, W_xkv, args.in[12], scr, r, lane); continue; } r -= I_XKV;
                if (r < I_XO) { p0_transpose_item(args.in[15], 1024, 1024, W_xo, nullptr, scr, r, lane); continue; } r -= I_XO;
                if (r < I_F1) { p0_transpose_item(args.in[17], 1024, FF, W_f1, args.in[16], scr, r, lane); continue; } r -= I_F1;
                p0_transpose_item(args.in[18], FF, 1024, W_f2, nullptr, scr, r, lane);
            }
            const int gt = bx * 512 + tid, NGT = G * 512;
            for (int i = gt; i < 2048; i += NGT) { const int d = i >> 10, f = i & 1023; const float l0 = args.in[6][d * 2048 + f], l1 = args.in[6][d * 2048 + 1024 + f]; LB[i] = 1.0f / (1.0f + __expf(l1 - l0)); }
            for (int i = gt; i < SEQ * 16; i += NGT) {
                const int pos = i >> 4, fi = i & 15;
                const float invt[16] = {1.0f, 0.44036659598350525f, 0.1939227432012558f, 0.08539710193872452f, 0.03760603070259094f, 0.016560440883040428f, 0.007292664609849453f, 0.0032114461064338684f,
                                        0.0014142135623842478f, 0.0006227724370546639f, 0.00027424818836152554f, 0.00012076973507646471f, 5.3182957344688475e-05f, 2.34199997066753e-05f, 1.0313385246263351e-05f, 4.541670477919979e-06f};
                float inv = invt[0];
#pragma unroll
                for (int k = 1; k < 16; ++k) inv = (fi == k) ? invt[k] : inv;
                const float x = (float)pos * inv;
                const float kq = rintf(x * 0.63661977236758134308f);
                float r = fmaf(-kq, 1.5707855225e+00f, x); r = fmaf(-kq, 1.0804273188e-05f, r); r = fmaf(-kq, 6.0770999344e-11f, r);
                const float r2 = r * r;
                const float sn = r + r * r2 * (-1.0f / 6 + r2 * (1.0f / 120 + r2 * (-1.0f / 5040 + r2 * (1.0f / 362880))));
                const float cn = 1.0f + r2 * (-0.5f + r2 * (1.0f / 24 + r2 * (-1.0f / 720 + r2 * (1.0f / 40320 + r2 * (-1.0f / 3628800)))));
                const int qd = ((int)kq) & 3;
                const float c = (qd == 0) ? cn : (qd == 1) ? -sn : (qd == 2) ? -cn : sn;
                const float s = (qd == 0) ? sn : (qd == 1) ? cn : (qd == 2) ? -sn : -cn;
                ROPE[2 * i] = c; ROPE[2 * i + 1] = s;
            }
            for (int m = gw; m < NSEQ * NMEM; m += NGW) { const float* src = (m < 512) ? args.in[2] + (size_t)m * DM : args.in[3] + (size_t)(m - 512) * DM; norm_row_bf16(src, MEMN + (size_t)m * DM, lane); }
            for (int m = gw; m < BROWS; m += NGW) norm_row_bf16(x_prompt + (size_t)m * DM, U + (size_t)m * DM, lane);
        } else {
            const int b = (ph - 1) / NPB, pp = (ph - 1) % NPB + 1; const int j = pp + (pp >= 7 ? 1 : 0) + (pp >= 10 ? 1 : 0); const bool rep2 = false;
            const float* xb = (b == 0) ? x_prompt : x_sample + (size_t)(b - 1) * BROWS * DM;
            float* hb = args.out + (size_t)b * BROWS * DM;
            bf16* Of = (bf16*)hb; bf16* Ob = Of + (size_t)BROWS * DM;
            if (j == 1) {
                TID_INIT
                { pg8::Gemm g{U, W_in, BROWS, NIN, DM, DM}; pg8::StaticOrder S; S.init(BROWS, NIN, G, bx); pg8::EpiIn E{P, LB, ROPE};
                  pg8::gemm_phase<pg8::EpiIn, true>(lds, g, S, E, tid); }
                if (b == 0) { pg8::Gemm g{MEMN, W_xkv, NSEQ * NMEM, 2048, DM, DM}; pg8::StaticOrder S; S.init(NSEQ * NMEM, 2048, G, (bx + G / 2) % G); pg8::EpiKV E{KMEM, VTMEM};
                  pg8::gemm_phase<pg8::EpiKV, true>(lds, g, S, E, tid); }
            } else if (j == 2) {
                TID_INIT
                for (int it = bx; it < 256; it += G) hgrn_item<1>(lds, P, Of, Ob, SEGL, SEGD, it, tid);
                { const int vcu = (G % 8 == 0) ? (bx % 8) * (G / 8) + bx / 8 : bx;
                  dattn_items(lds, P, LSE, vcu, G, 1536, tid); }
            } else if (j == 3) {
                TID_INIT
                for (int it = bx; it < 256; it += G) hgrn_item<2>(lds, P, Of, Ob, SEGL, SEGD, it, tid);
            } else if (j == 4) {
                TID_INIT
                for (int m = gw; m < BROWS; m += NGW) post_row(P, m, Of + (size_t)m * DM, Ob + (size_t)m * DM, LSE + (size_t)m * 12, args.in[7], U + (size_t)m * DM, lane);
            } else if (j == 5) {
                TID_INIT
                { pg8::Gemm g{U, W_ho, BROWS, DM, DM, DM}; pg8::StaticOrder S; S.init(BROWS, DM, G, bx); pg8::EpiY<1> E{P}; pg8::gemm_phase<pg8::EpiY<1>, true>(lds, g, S, E, tid); }
                { pg8::Gemm g{P + OFF_ATT0, W_ao, BROWS, DM, 512, 512}; pg8::StaticOrder S; S.init(BROWS, DM, G, bx); pg8::EpiY<2> E{P}; pg8::gemm_phase<pg8::EpiY<2>, true>(lds, g, S, E, tid); }
            } else if (j == 6 || j == 10 || j == 13) {
                TID_INIT
                pg8::StaticOrder S; S.init(BROWS, DM, G, bx);
                if (j == 6) { pg8::Gemm g{P + OFF_GH, W_out, BROWS, DM, DM, 1024}; pg8::EpiRes<0> E{xb, nullptr, U, SS}; pg8::gemm_phase<pg8::EpiRes<0>, true>(lds, g, S, E, tid); }
                else if (j == 10) { pg8::Gemm g{P, W_xo, BROWS, DM, DM, DM}; pg8::EpiRes<1> E{nullptr, nullptr, U, SS + (size_t)BROWS * 16}; pg8::gemm_phase<pg8::EpiRes<1>, true>(lds, g, S, E, tid); }
                else { pg8::Gemm g{P, W_f2, BROWS, DM, FF, FF}; pg8::EpiRes<2> E{nullptr, hb, U, SS + (size_t)2 * BROWS * 16}; pg8::gemm_phase<pg8::EpiRes<2>, true>(lds, g, S, E, tid); }
            } else if (j == 7 || j == 11) {
                TID_INIT
                for (int m = gw; m < BROWS; m += NGW) norm_row_bf16(hb + (size_t)m * DM, U + (size_t)m * DM, lane);
            } else if (j == 8) {
                TID_INIT
                pg8::Gemm g{U, W_xq, BROWS, DM, DM, DM}; pg8::StaticOrder S; S.init(BROWS, DM, G, bx); pg8::EpiBf<0> E{P, DM, QSCALE_X, SS}; pg8::gemm_phase<pg8::EpiBf<0>, true>(lds, g, S, E, tid);
            } else if (j == 9) {
                TID_INIT
                for (int it = bx; it < 512; it += G) xattn_item(lds, P, KMEM, VTMEM, b, it, tid);
            } else if (j == 12) {
                TID_INIT
                pg8::Gemm g{U, W_f1, BROWS, FF, DM, DM}; pg8::StaticOrder S; S.init(BROWS, FF, G, bx); pg8::EpiBf<1> E{P, FF, 1.0f, SS + (size_t)BROWS * 16}; pg8::gemm_phase<pg8::EpiBf<1>, true>(lds, g, S, E, tid);
            } else {
                TID_INIT
                for (int m = gw; m < BROWS; m += NGW) final_row_ss(hb + (size_t)m * DM, args.in[19], SS + ((size_t)2 * BROWS + m) * 16, lane);
                if (b + 1 < NBATCH) { const float* xn = x_sample + (size_t)b * BROWS * DM; for (int m = gw; m < BROWS; m += NGW) norm_row_bf16(xn + (size_t)m * DM, U + (size_t)m * DM, lane); }
            }
        }
        if (ph + 1 < args.ph_hi) { if (ph == 0) { __threadfence(); grid.sync(); } else xcd_barrier(xbar); }
        else __syncthreads();
    }
}

extern "C" void kernel_launch(void* const* d_in, const int* in_sizes, int n_in, void* d_out, int out_size, void* d_ws, size_t ws_size, hipStream_t stream) {
    static int grid = 0;
    if (grid == 0) {
        if (n_in != 20 || ws_size < WS_END) { fprintf(stderr, "kernel_launch: unexpected n_in %d / ws_size %zu\n", n_in, ws_size); grid = -1; return; }
        int dev = 0, cus = 0, per_cu = 0;
        hipGetDevice(&dev); hipDeviceGetAttribute(&cus, hipDeviceAttributeMultiprocessorCount, dev);
        if (hipFuncSetAttribute((const void*)fwd_kernel, hipFuncAttributeMaxDynamicSharedMemorySize, LDS_BYTES) != hipSuccess) { fprintf(stderr, "kernel_launch: hipFuncSetAttribute failed\n"); grid = -1; return; }
        hipOccupancyMaxActiveBlocksPerMultiprocessor(&per_cu, (const void*)fwd_kernel, 512, LDS_BYTES);
        (void)hipGetLastError();
        if (per_cu < 1) per_cu = 1;
        grid = cus;
        fprintf(stderr, "kernel_launch: cus %d per_cu %d grid %d\n", cus, per_cu, grid);
    }
    if (grid < 0) return;
    Args a{};
    for (int i = 0; i < 20; ++i) a.in[i] = (const float*)d_in[i];
    a.out = (float*)d_out; a.ws = (unsigned char*)d_ws;
#if ONE_LAUNCH
    if (hipMemsetAsync((char*)d_ws + WS_CTL, 0, CTL_BYTES, stream) != hipSuccess) { fprintf(stderr, "kernel_launch: memset failed\n"); return; }
    a.ph_lo = 0; a.ph_hi = NPH;
    void* kargs[] = {&a};
    hipError_t e = hipLaunchCooperativeKernel((const void*)fwd_kernel, dim3(grid), dim3(512), kargs, LDS_BYTES, stream);
    if (e != hipSuccess) fprintf(stderr, "cooperative launch failed: %s (grid %d)\n", hipGetErrorString(e), grid);
#else
    for (int ph = 0; ph < NPH; ++ph) {
        a.ph_lo = ph; a.ph_hi = ph + 1;
        hipLaunchKernelGGL(fwd_kernel, dim3(grid), dim3(512), LDS_BYTES, stream, a);
    }
#endif
}
```

```cpp
#include <hip/hip_runtime.h>
#include <hip/hip_cooperative_groups.h>
#include <cstdio>
#include <cstdint>
namespace cg = cooperative_groups;

#ifndef DBL
#define DBL 0
#endif
#ifndef ONE_LAUNCH
#define ONE_LAUNCH 1
#endif

#define DI __device__ __forceinline__
#define LAS __attribute__((address_space(3)))
typedef unsigned short bf16;
typedef short bf16x8 __attribute__((ext_vector_type(8)));
typedef short s16x4 __attribute__((ext_vector_type(4)));
typedef float f32x4 __attribute__((ext_vector_type(4)));
typedef float f32x2 __attribute__((ext_vector_type(2)));
typedef unsigned u32x4 __attribute__((ext_vector_type(4)));
typedef unsigned u32x2 __attribute__((ext_vector_type(2)));

constexpr int DM = 1024, SEQ = 8192, NSEQ = 6, TTOK = NSEQ * SEQ, BROWS = 2 * SEQ  , NBATCH = 3;
constexpr int NIN = 11776, FF = 4096, NMEM = 256;
constexpr int C_Q = 0, C_FF = 1024, C_FB = 2048, C_V = 3072, C_G = 4096, C_ATT = 5120, C_GH = 9728, C_GA = 10752;
constexpr size_t PE1 = (size_t)BROWS * 1024, PE2 = (size_t)BROWS * 512;
constexpr size_t OFF_Q = 0, OFF_FF = PE1, OFF_V = 3 * PE1, OFF_G = 4 * PE1, OFF_ATT0 = 5 * PE1, OFF_GH = 5 * PE1 + 9 * PE2, OFF_GA = OFF_GH + PE1;
constexpr float RMS_EPS = 1e-6f;
constexpr float QSCALE_A = 0.08838834764831845f * 1.4426950408889634f;
constexpr float QSCALE_X = 0.0625f * 1.4426950408889634f;

constexpr size_t MiB = 1u << 20;
constexpr int LDS_BYTES_ = 147456, LDS_BYTES = LDS_BYTES_;
constexpr size_t WS_WIN = 0, WS_WHO = 23 * MiB, WS_WAO = 25 * MiB, WS_WOUT = 26 * MiB, WS_WXQ = 28 * MiB, WS_WXKV = 30 * MiB, WS_WXO = 34 * MiB,
                 WS_WF1 = 36 * MiB, WS_WF2 = 44 * MiB;
constexpr size_t WS_LB = 52 * MiB, WS_ROPE = 52 * MiB + 65536, WS_SEGD = 53 * MiB + 524288, WS_MEMN = 54 * MiB, WS_KMEM = 57 * MiB, WS_VTMEM = 60 * MiB,
                 WS_LSE = 63 * MiB, WS_SEGL = 64 * MiB, WS_U = 80 * MiB, WS_P = 112 * MiB, WS_CTL = 480 * MiB, WS_END = 485 * MiB;
constexpr size_t CTL_BYTES = 16384;
constexpr size_t WS_SS = 481 * MiB;
constexpr int LDS_BARST = LDS_BYTES_ - 64;


DI float bf2f(unsigned short h) { return __uint_as_float((unsigned)h << 16); }
DI unsigned short f2bf(float f) { unsigned u = __float_as_uint(f); return (unsigned short)((u + 0x7fffu + ((u >> 16) & 1u)) >> 16); }
DI unsigned pk2(float lo, float hi) { return (unsigned)f2bf(lo) | ((unsigned)f2bf(hi) << 16); }
DI float lo_f(unsigned u) { return __uint_as_float(u << 16); }
DI float hi_f(unsigned u) { return __uint_as_float(u & 0xffff0000u); }
DI float sigmoidf_(float x) { return __builtin_amdgcn_rcpf(1.0f + __builtin_amdgcn_exp2f(x * -1.4426950408889634f)); }
DI unsigned cvtpk(float lo, float hi) { unsigned r; asm volatile("v_cvt_pk_bf16_f32 %0, %1, %2" : "=v"(r) : "v"(lo), "v"(hi)); return r; }
DI float ex2(float x) { return __builtin_amdgcn_exp2f(x); }
DI float wave_sum(float v) {
#pragma unroll
    for (int o = 1; o < 64; o <<= 1) v += __shfl_xor(v, o);
    return v;
}
#define MFMA16(a, b, c) __builtin_amdgcn_mfma_f32_16x16x32_bf16((a), (b), (c), 0, 0, 0)

namespace pg8 {
constexpr int BM = 256, BK = 64, HALF = 128, HTB = HALF * BK * 2, STAGE_BYTES = 8 * HTB, NXCD = 8, WGM = 2;
DI int lds_byte(int r, int c) { const int st = (r >> 4) * 2 + (c >> 5), rr = r & 15, cc = c & 31, ob = rr * 64 + cc * 2; return st * 1024 + (ob ^ (((ob >> 9) & 1) << 5)); }
DI void stage_rc(int b, int& R, int& C) { const int st = b / 1024, sb = b % 1024, swz = sb ^ (((sb >> 9) & 1) << 5); R = (st >> 1) * 16 + swz / 64; C = (st & 1) * 32 + (swz % 64) / 2; }
DI int perm32(int rho) { const int n = rho >> 4, i = rho & 15; return 8 * (i >> 2) + 4 * n + (i & 3); }
struct Unit { int pm, pn; };
struct Gemm { const bf16* A; const bf16* Bt; int M, N, K, lda; };
struct StaticOrder {
    int nM, nN, nwg, G, c;
    DI void init(int M, int N, int G_, int c_) { nM = M / BM; nN = N / BM; nwg = nM * nN; G = G_; c = c_; }
    DI bool next(int i, Unit& u) const {
        const long L = (long)i * G + c; if (L >= nwg) return false;
        int wgid = (int)L; { const int q = nwg / NXCD, r = nwg % NXCD, xcd = wgid % NXCD, off = wgid / NXCD; wgid = (xcd < r ? xcd * (q + 1) : r * (q + 1) + (xcd - r) * q) + off; }
        const int nig = WGM * nN, gid = wgid / nig, fm = gid * WGM, gsz = (nM - fm) < WGM ? (nM - fm) : WGM;
        u.pm = fm + ((wgid % nig) % gsz); u.pn = (wgid % nig) / gsz; return true;
    }
};
DI unsigned cvt_pk_bf16(float lo, float hi) { unsigned r; asm volatile("v_cvt_pk_bf16_f32 %0, %1, %2" : "=v"(r) : "v"(lo), "v"(hi)); return r; }

template <class Epi, bool ALIGN_EPI>
DI void gemm_phase(LAS unsigned char* lds, const Gemm g, const StaticOrder& S, const Epi& E, const int tid) {
    const int wid = __builtin_amdgcn_readfirstlane(tid >> 6), lane = tid & 63, wr = wid >> 2, wc = wid & 3, fr = lane & 15, fq = lane >> 4;
    const int K = g.K, nt = K / BK;
    unsigned voffA[2], voffB[2];
#pragma unroll
    for (int i = 0; i < 2; ++i) { int R, C; stage_rc(tid * 16 + i * 8192, R, C); const int Rb = Epi::PERM ? ((R & ~31) + perm32(R & 31)) : R;
        voffA[i] = (unsigned)(R * g.lda + C) * 2u; voffB[i] = (unsigned)(Rb * K + C) * 2u; }
    const size_t kstep = (size_t)(BK * 2);
    const size_t hstepA = (size_t)HALF * g.lda * 2, hstepB = (size_t)HALF * K * 2;
    const size_t tstepA = 2 * hstepA, tstepB = 2 * hstepB;
    const unsigned ldsw = (unsigned)wid * 1024u;
    const int aoff = lds_byte(wr * 64 + fr, fq * 8), boff = lds_byte(wc * 32 + fr, fq * 8);
#define PG8_SA(b, h) (((b) * 2 + (h)) * HTB)
#define PG8_SB(b, h) ((4 + (b) * 2 + (h)) * HTB)
#define PG8_STAGE(bufoff, gbase, voff) do { _Pragma("unroll") for (int _i = 0; _i < 2; ++_i) \
        __builtin_amdgcn_global_load_lds((const unsigned*)((const char*)(gbase) + (voff)[_i]), (LAS unsigned*)(lds + (bufoff) + ldsw + _i * 8192), 16, 0, 0); } while (0)
#define PG8_LDA(dst, b, h) do { _Pragma("unroll") for (int m = 0; m < 4; ++m) _Pragma("unroll") for (int k = 0; k < 2; ++k) dst[m][k] = *(const LAS bf16x8*)(lds + PG8_SA(b, h) + aoff + m * 2048 + k * 1024); } while (0)
#define PG8_LDB(dst, b, h) do { _Pragma("unroll") for (int n = 0; n < 2; ++n) _Pragma("unroll") for (int k = 0; k < 2; ++k) dst[n][k] = *(const LAS bf16x8*)(lds + PG8_SB(b, h) + boff + n * 2048 + k * 1024); } while (0)
#define PG8_MMA(ai, bj, At, Bt) do { __builtin_amdgcn_s_setprio(1); _Pragma("unroll") for (int m = 0; m < 4; ++m) _Pragma("unroll") for (int n = 0; n < 2; ++n) _Pragma("unroll") for (int k = 0; k < 2; ++k) \
        acc[ai][bj][m][n] = __builtin_amdgcn_mfma_f32_16x16x32_bf16(Bt[n][k], At[m][k], acc[ai][bj][m][n], 0, 0, 0); __builtin_amdgcn_s_setprio(0); } while (0)
#define PG8_WAIT_V(n) asm volatile("s_waitcnt vmcnt(" #n ")" ::: "memory")
#define PG8_WAIT_L(n) asm volatile("s_waitcnt lgkmcnt(" #n ")" ::: "memory")
#define PG8_BAR __builtin_amdgcn_s_barrier()
#define PG8_SCHED __builtin_amdgcn_sched_barrier(0)
    Unit cur, nxt; int ui = 0;
    if (!S.next(0, cur)) return;
    f32x4 acc[2][2][4][2];
#pragma unroll
    for (int a = 0; a < 2; ++a)
#pragma unroll
        for (int b = 0; b < 2; ++b)
#pragma unroll
            for (int m = 0; m < 4; ++m)
#pragma unroll
                for (int n = 0; n < 2; ++n) acc[a][b][m][n] = (f32x4){0.f, 0.f, 0.f, 0.f};
    bf16x8 At[4][2], B0[2][2], B1[2][2];
    const char* cA = (const char*)g.A + (size_t)cur.pm * tstepA; const char* cB = (const char*)g.Bt + (size_t)cur.pn * tstepB;
    PG8_STAGE(PG8_SB(0, 0), cB, voffB); PG8_STAGE(PG8_SB(0, 1), cB + hstepB, voffB); PG8_STAGE(PG8_SA(0, 0), cA, voffA); PG8_STAGE(PG8_SA(0, 1), cA + hstepA, voffA);
    if (wr == 1) PG8_BAR;
    PG8_WAIT_V(2); PG8_BAR;
    PG8_STAGE(PG8_SB(1, 0), cB + kstep, voffB); PG8_STAGE(PG8_SA(1, 0), cA + kstep, voffA); PG8_STAGE(PG8_SB(1, 1), cB + hstepB + kstep, voffB);
    PG8_WAIT_V(6); PG8_BAR;
    for (;;) {
        const bool has_next = S.next(ui + 1, nxt);
        const char* nA = has_next ? (const char*)g.A + (size_t)nxt.pm * tstepA : cA; const char* nB = has_next ? (const char*)g.Bt + (size_t)nxt.pn * tstepB : cB;
        for (int t = 0; t < nt; t += 2) {
            const bool last = (t == nt - 2);
            const char* a1 = cA + (size_t)(t + 1) * kstep;
            const char* a2 = last ? nA : cA + (size_t)(t + 2) * kstep; const char* b2 = last ? nB : cB + (size_t)(t + 2) * kstep;
            const char* a3 = a2 + kstep; const char* b3 = b2 + kstep;
            PG8_LDB(B0, 0, 0); PG8_LDB(B1, 0, 1); PG8_SCHED; PG8_LDA(At, 0, 0); PG8_STAGE(PG8_SA(1, 1), a1 + hstepA, voffA);
            PG8_WAIT_V(8); PG8_WAIT_L(0); PG8_BAR; PG8_MMA(0, 0, At, B0); PG8_MMA(0, 1, At, B1); PG8_BAR; PG8_SCHED;
            PG8_LDA(At, 0, 1); PG8_STAGE(PG8_SB(0, 0), b2, voffB); PG8_STAGE(PG8_SB(0, 1), b2 + hstepB, voffB); PG8_STAGE(PG8_SA(0, 0), a2, voffA);
            PG8_WAIT_V(8); PG8_WAIT_L(0); PG8_BAR; PG8_MMA(1, 0, At, B0); PG8_MMA(1, 1, At, B1); PG8_BAR; PG8_SCHED;
            PG8_LDB(B0, 1, 0); PG8_LDB(B1, 1, 1); PG8_SCHED; PG8_LDA(At, 1, 0); PG8_STAGE(PG8_SA(0, 1), a2 + hstepA, voffA);
            PG8_WAIT_V(8); PG8_WAIT_L(0); PG8_BAR; PG8_MMA(0, 0, At, B0); PG8_MMA(0, 1, At, B1); PG8_BAR; PG8_SCHED;
            PG8_LDA(At, 1, 1); PG8_STAGE(PG8_SB(1, 0), b3, voffB); PG8_STAGE(PG8_SB(1, 1), b3 + hstepB, voffB); PG8_STAGE(PG8_SA(1, 0), a3, voffA);
            PG8_WAIT_V(8); PG8_WAIT_L(0); PG8_BAR; PG8_MMA(1, 0, At, B0); PG8_MMA(1, 1, At, B1); PG8_BAR; PG8_SCHED;
        }
        if constexpr (ALIGN_EPI) { if (wr == 0) PG8_BAR; }
        E(acc, cur, wr, wc, fr, fq);
        if (!has_next) break;
#pragma unroll
        for (int a = 0; a < 2; ++a)
#pragma unroll
            for (int b = 0; b < 2; ++b)
#pragma unroll
                for (int m = 0; m < 4; ++m)
#pragma unroll
                    for (int n = 0; n < 2; ++n) acc[a][b][m][n] = (f32x4){0.f, 0.f, 0.f, 0.f};
        cur = nxt; cA = nA; cB = nB; ++ui;
        if constexpr (ALIGN_EPI) { if (wr == 1) PG8_BAR; }
    }
    PG8_WAIT_V(0);
    if constexpr (!ALIGN_EPI) { if (wr == 0) PG8_BAR; }
    PG8_BAR;
#undef PG8_SA
#undef PG8_SB
#undef PG8_STAGE
#undef PG8_LDA
#undef PG8_LDB
#undef PG8_MMA
#undef PG8_WAIT_V
#undef PG8_WAIT_L
#undef PG8_BAR
#undef PG8_SCHED
}

struct EpiIn {
    static constexpr bool PERM = true;
    bf16* P; const float* lb; const float* rope;
    DI void operator()(const f32x4 (&acc)[2][2][4][2], const Unit& u, int wr, int wc, int fr, int fq) const {
        const int seg = u.pn >> 1;
        int type, dir = 0;
        if (seg < 2) type = 0; else if (seg < 6) { type = 1; dir = (seg >= 4) ? 1 : 0; } else if (seg < 8) type = 2; else if (seg < 10) type = 0;
        else if (seg < 19) { const int t = (seg - 10) % 3; type = (t == 0) ? 4 : ((t == 1) ? 5 : 2); } else type = 3;
#pragma unroll
        for (int ai = 0; ai < 2; ++ai)
#pragma unroll
            for (int m = 0; m < 4; ++m) {
                const int row = u.pm * BM + ai * HALF + wr * 64 + m * 16 + fr;
                const int c0t = u.pn * BM;
                size_t toff; int pitch, lc;
                if (c0t < C_ATT) { toff = (size_t)(c0t >> 10) * PE1; pitch = 1024; lc = c0t & 1023; }
                else if (c0t < C_GH) { toff = OFF_ATT0 + (size_t)((c0t - C_ATT) >> 9) * PE2; pitch = 512; lc = (c0t - C_ATT) & 511; }
                else { toff = OFF_GH + (size_t)((c0t - C_GH) >> 10) * PE1; pitch = 1024; lc = (c0t - C_GH) & 1023; }
                bf16* rowp = P + toff + (size_t)row * pitch + lc;
#pragma unroll
                for (int bj = 0; bj < 2; ++bj) {
                    const int col0 = u.pn * BM + bj * HALF + wc * 32 + 8 * fq;
                    f32x4 v0 = acc[ai][bj][m][0], v1 = acc[ai][bj][m][1];
                    if (type == 0) {
#pragma unroll
                        for (int i = 0; i < 4; ++i) { v0[i] = v0[i] * sigmoidf_(v0[i]); v1[i] = v1[i] * sigmoidf_(v1[i]); }
                    } else if (type == 1) {
                        const float* lbp = lb + dir * 1024 + (col0 - (C_FF + 1024 * dir));
                        const f32x4 l0 = *(const f32x4*)lbp, l1 = *(const f32x4*)(lbp + 4);
#pragma unroll
                        for (int i = 0; i < 4; ++i) { v0[i] = __logf(l0[i] + (1.0f - l0[i]) * sigmoidf_(v0[i])); v1[i] = __logf(l1[i] + (1.0f - l1[i]) * sigmoidf_(v1[i])); }
                    } else if (type == 3) {
#pragma unroll
                        for (int i = 0; i < 4; ++i) { v0[i] = sigmoidf_(v0[i]); v1[i] = sigmoidf_(v1[i]); }
                    } else if (type == 4 || type == 5) {
                        if (wc == 0) {
                            const int pos = row & (SEQ - 1);
                            const float* rp = rope + ((size_t)pos * 16 + 8 * (fq & 1)) * 2;
                            const f32x4 ca = *(const f32x4*)rp, cb = *(const f32x4*)(rp + 4), cc = *(const f32x4*)(rp + 8), cd = *(const f32x4*)(rp + 12);
                            const float c[8] = {ca[0], ca[2], cb[0], cb[2], cc[0], cc[2], cd[0], cd[2]}, sn[8] = {ca[1], ca[3], cb[1], cb[3], cc[1], cc[3], cd[1], cd[3]};
                            const float sg = (fq < 2) ? -1.0f : 1.0f;
#pragma unroll
                            for (int i = 0; i < 4; ++i) {
                                const float p0 = __shfl_xor(v0[i], 32), p1 = __shfl_xor(v1[i], 32);
                                v0[i] = v0[i] * c[i] + sg * p0 * sn[i]; v1[i] = v1[i] * c[4 + i] + sg * p1 * sn[4 + i];
                            }
                        }
                        if (type == 4) { v0 = v0 * QSCALE_A; v1 = v1 * QSCALE_A; }
                    }
                    u32x4 w; w.x = cvt_pk_bf16(v0[0], v0[1]); w.y = cvt_pk_bf16(v0[2], v0[3]); w.z = cvt_pk_bf16(v1[0], v1[1]); w.w = cvt_pk_bf16(v1[2], v1[3]);
                    *(u32x4*)(rowp + bj * HALF + wc * 32 + 8 * fq) = w;
                }
            }
    }
};
struct EpiKV {
    static constexpr bool PERM = false;
    bf16* Km; bf16* Vt;
    DI void operator()(const f32x4 (&acc)[2][2][4][2], const Unit& u, int wr, int wc, int fr, int fq) const {
#pragma unroll
        for (int ai = 0; ai < 2; ++ai)
#pragma unroll
            for (int m = 0; m < 4; ++m) {
                const int row = u.pm * BM + ai * HALF + wr * 64 + m * 16 + fr;
#pragma unroll
                for (int bj = 0; bj < 2; ++bj)
#pragma unroll
                    for (int n = 0; n < 2; ++n) {
                        const int col0 = u.pn * BM + bj * HALF + wc * 32 + 16 * n + 4 * fq; const f32x4 v = acc[ai][bj][m][n];
                        if (col0 < 1024) { u32x2 w; w.x = cvt_pk_bf16(v[0], v[1]); w.y = cvt_pk_bf16(v[2], v[3]); *(u32x2*)(Km + (size_t)row * 1024 + col0) = w; }
                        else { const int cv = col0 - 1024, head = cv >> 8, d = cv & 255, sq = row >> 8, key = row & 255;
#pragma unroll
                            for (int i = 0; i < 4; ++i) Vt[((size_t)((sq * 4 + head) * 256 + d + i)) * 256 + key] = f2bf(v[i]); }
                    }
            }
    }
};
template <int WHICH> struct EpiY {
    static constexpr bool PERM = true;
    bf16* P;
    DI void operator()(const f32x4 (&acc)[2][2][4][2], const Unit& u, int wr, int wc, int fr, int fq) const {
#pragma unroll
        for (int ai = 0; ai < 2; ++ai)
#pragma unroll
            for (int m = 0; m < 4; ++m) {
                const int row = u.pm * BM + ai * HALF + wr * 64 + m * 16 + fr;
#pragma unroll
                for (int bj = 0; bj < 2; ++bj) {
                    const int col0 = u.pn * BM + bj * HALF + wc * 32 + 8 * fq;
                    bf16* gp = P + OFF_GH + (size_t)row * 1024 + col0;
                    const u32x4 gh = *(const u32x4*)gp;
                    const f32x4 a0 = acc[ai][bj][m][0], a1 = acc[ai][bj][m][1];
                    float o[8];
                    if (WHICH == 1) {
                        o[0] = lo_f(gh.x) * a0[0]; o[1] = hi_f(gh.x) * a0[1]; o[2] = lo_f(gh.y) * a0[2]; o[3] = hi_f(gh.y) * a0[3];
                        o[4] = lo_f(gh.z) * a1[0]; o[5] = hi_f(gh.z) * a1[1]; o[6] = lo_f(gh.w) * a1[2]; o[7] = hi_f(gh.w) * a1[3];
                    } else {
                        const u32x4 ga = *(const u32x4*)(gp + PE1);
                        o[0] = lo_f(gh.x) + lo_f(ga.x) * a0[0]; o[1] = hi_f(gh.x) + hi_f(ga.x) * a0[1]; o[2] = lo_f(gh.y) + lo_f(ga.y) * a0[2]; o[3] = hi_f(gh.y) + hi_f(ga.y) * a0[3];
                        o[4] = lo_f(gh.z) + lo_f(ga.z) * a1[0]; o[5] = hi_f(gh.z) + hi_f(ga.z) * a1[1]; o[6] = lo_f(gh.w) + lo_f(ga.w) * a1[2]; o[7] = hi_f(gh.w) + hi_f(ga.w) * a1[3];
                    }
                    u32x4 w; w.x = cvt_pk_bf16(o[0], o[1]); w.y = cvt_pk_bf16(o[2], o[3]); w.z = cvt_pk_bf16(o[4], o[5]); w.w = cvt_pk_bf16(o[6], o[7]);
                    *(u32x4*)gp = w;
                }
            }
    }
};
template <int MODE> struct EpiRes {
    static constexpr bool PERM = true;
    const float* xin; float* out; bf16* hb16; float* ss;
    DI void operator()(const f32x4 (&acc)[2][2][4][2], const Unit& u, int wr, int wc, int fr, int fq) const {
#pragma unroll
        for (int ai = 0; ai < 2; ++ai)
#pragma unroll
            for (int m = 0; m < 4; ++m) {
                const int row = u.pm * BM + ai * HALF + wr * 64 + m * 16 + fr;
                const size_t off = (size_t)row * DM + u.pn * BM + wc * 32 + 8 * fq;
                float part = 0.f;
#pragma unroll
                for (int bj = 0; bj < 2; ++bj) {
                    f32x4 v0, v1;
                    if (MODE == 0) { v0 = *(const f32x4*)(xin + off + bj * HALF); v1 = *(const f32x4*)(xin + off + bj * HALF + 4); }
                    else { const u32x4 hb = *(const u32x4*)(hb16 + off + bj * HALF); v0 = (f32x4){lo_f(hb.x), hi_f(hb.x), lo_f(hb.y), hi_f(hb.y)}; v1 = (f32x4){lo_f(hb.z), hi_f(hb.z), lo_f(hb.w), hi_f(hb.w)}; }
                    v0 = v0 + acc[ai][bj][m][0]; v1 = v1 + acc[ai][bj][m][1];
                    if (MODE == 2) { *(f32x4*)(out + off + bj * HALF) = v0; *(f32x4*)(out + off + bj * HALF + 4) = v1; }
                    else { u32x4 w; w.x = cvt_pk_bf16(v0[0], v0[1]); w.y = cvt_pk_bf16(v0[2], v0[3]); w.z = cvt_pk_bf16(v1[0], v1[1]); w.w = cvt_pk_bf16(v1[2], v1[3]); *(u32x4*)(hb16 + off + bj * HALF) = w;
                        v0 = (f32x4){lo_f(w.x), hi_f(w.x), lo_f(w.y), hi_f(w.y)}; v1 = (f32x4){lo_f(w.z), hi_f(w.z), lo_f(w.w), hi_f(w.w)}; }
                    part += (v0[0] * v0[0] + v0[1] * v0[1]) + (v0[2] * v0[2] + v0[3] * v0[3]) + (v1[0] * v1[0] + v1[1] * v1[1]) + (v1[2] * v1[2] + v1[3] * v1[3]);
                }
                part += __shfl_xor(part, 16); part += __shfl_xor(part, 32); if (fq == 0) ss[(size_t)row * 16 + u.pn * 4 + wc] = part;
            }
    }
};
template <int ACT> struct EpiBf {
    static constexpr bool PERM = true;
    bf16* O; int ldc; float scale; const float* ss;
    DI void operator()(const f32x4 (&acc)[2][2][4][2], const Unit& u, int wr, int wc, int fr, int fq) const {
#pragma unroll
        for (int ai = 0; ai < 2; ++ai)
#pragma unroll
            for (int m = 0; m < 4; ++m) {
                const int row = u.pm * BM + ai * HALF + wr * 64 + m * 16 + fr;
                bf16* rowp = O + (size_t)row * ldc + u.pn * BM + wc * 32 + 8 * fq;
                float ssum; { const f32x4* sp = (const f32x4*)(ss + (size_t)row * 16); const f32x4 s0 = sp[0], s1 = sp[1], s2 = sp[2], s3 = sp[3];
                    ssum = ((s0[0] + s0[1]) + (s0[2] + s0[3])) + ((s1[0] + s1[1]) + (s1[2] + s1[3])) + ((s2[0] + s2[1]) + (s2[2] + s2[3])) + ((s3[0] + s3[1]) + (s3[2] + s3[3])); }
                const float rstd = rsqrtf(ssum * (1.0f / DM) + RMS_EPS);
                const float sc = (ACT == 1) ? rstd * rstd : rstd * scale;
#pragma unroll
                for (int bj = 0; bj < 2; ++bj) {
                    f32x4 v0 = acc[ai][bj][m][0], v1 = acc[ai][bj][m][1];
                    if (ACT == 1) {
#pragma unroll
                        for (int i = 0; i < 4; ++i) { const float a = fmaxf(v0[i], 0.f), b = fmaxf(v1[i], 0.f); v0[i] = a * a * sc; v1[i] = b * b * sc; }
                    } else { v0 = v0 * sc; v1 = v1 * sc; }
                    u32x4 w; w.x = cvt_pk_bf16(v0[0], v0[1]); w.y = cvt_pk_bf16(v0[2], v0[3]); w.z = cvt_pk_bf16(v1[0], v1[1]); w.w = cvt_pk_bf16(v1[2], v1[3]);
                    *(u32x4*)(rowp + bj * HALF) = w;
                }
            }
    }
};
}

DI void p0_transpose_item(const float* W, int K, int N, bf16* WT, const float* gain, LAS float* scr, int item, int lane) {
    const int nblk = N / 32, kb = item / nblk, nb = item % nblk, k0 = 64 * kb, n0 = 32 * nb;
    float wv[32];
#pragma unroll
    for (int i = 0; i < 32; ++i) { const int kk = 2 * i + (lane >> 5); wv[i] = W[(size_t)(k0 + kk) * N + n0 + (lane & 31)]; }
    if (gain) {
#pragma unroll
        for (int i = 0; i < 32; ++i) wv[i] *= gain[k0 + 2 * i + (lane >> 5)];
    }
#pragma unroll
    for (int i = 0; i < 32; ++i) { const int kk = 2 * i + (lane >> 5); scr[kk * 33 + (lane & 31)] = wv[i]; }
    asm volatile("s_waitcnt lgkmcnt(0)" ::: "memory");
    const int c = lane & 7;
#pragma unroll
    for (int j = 0; j < 4; ++j) { const int n = (lane >> 3) + 8 * j; const LAS float* s = scr + (8 * c) * 33 + n;
        u32x4 o; o.x = pk2(s[0 * 33], s[1 * 33]); o.y = pk2(s[2 * 33], s[3 * 33]); o.z = pk2(s[4 * 33], s[5 * 33]); o.w = pk2(s[6 * 33], s[7 * 33]);
        *(u32x4*)(WT + (size_t)(n0 + n) * K + k0 + 8 * c) = o; }
    asm volatile("s_waitcnt lgkmcnt(0)" ::: "memory");
}
DI void norm_row_bf16(const float* xrow, bf16* orow, int lane) {
    const f32x4* xr = (const f32x4*)xrow + lane;
    f32x4 v[4]; float s = 0.f;
#pragma unroll
    for (int j = 0; j < 4; ++j) { v[j] = xr[64 * j]; s += (v[j].x * v[j].x + v[j].y * v[j].y) + (v[j].z * v[j].z + v[j].w * v[j].w); }
    const float rstd = rsqrtf(wave_sum(s) * (1.f / DM) + RMS_EPS);
    u32x2* o8 = (u32x2*)orow + lane;
#pragma unroll
    for (int j = 0; j < 4; ++j) { u32x2 w; w.x = pk2(v[j].x * rstd, v[j].y * rstd); w.y = pk2(v[j].z * rstd, v[j].w * rstd); o8[64 * j] = w; }
}
DI void final_row_ss(float* hrow, const float* g, const float* ssp, int lane) {
    f32x4* xr = (f32x4*)hrow + lane; const f32x4* gr = (const f32x4*)g + lane;
    const f32x4 s0 = ((const f32x4*)ssp)[0], s1 = ((const f32x4*)ssp)[1], s2 = ((const f32x4*)ssp)[2], s3 = ((const f32x4*)ssp)[3];
    const float ssrow = ((s0[0] + s0[1]) + (s0[2] + s0[3])) + ((s1[0] + s1[1]) + (s1[2] + s1[3])) + ((s2[0] + s2[1]) + (s2[2] + s2[3])) + ((s3[0] + s3[1]) + (s3[2] + s3[3]));
    const float rstd = rsqrtf(ssrow * (1.f / DM) + RMS_EPS);
    f32x4 v[4];
#pragma unroll
    for (int j = 0; j < 4; ++j) v[j] = xr[64 * j];
#pragma unroll
    for (int j = 0; j < 4; ++j) xr[64 * j] = v[j] * rstd * gr[64 * j];
}
DI void final_row(float* hrow, const float* g, int lane) {
    f32x4* xr = (f32x4*)hrow + lane; const f32x4* gr = (const f32x4*)g + lane;
    f32x4 v[4]; float s = 0.f;
#pragma unroll
    for (int j = 0; j < 4; ++j) { v[j] = xr[64 * j]; s += (v[j].x * v[j].x + v[j].y * v[j].y) + (v[j].z * v[j].z + v[j].w * v[j].w); }
    const float rstd = rsqrtf(wave_sum(s) * (1.f / DM) + RMS_EPS);
#pragma unroll
    for (int j = 0; j < 4; ++j) xr[64 * j] = v[j] * rstd * gr[64 * j];
}

constexpr int HG_QD = 0, HG_KD = 17408, HG_QS = 34816, HG_K0E = 52224, HG_KST = 60928, HG_VT = 79360, HG_AM = 97792, HG_TOT = 107008, HG_DL = 109056;
template <int PASS>
DI void hgrn_item(LAS unsigned char* lds, const bf16* Pb, bf16* Of, bf16* Ob, float* segL, float* segD, int item, int tid) {
    const int lane = tid & 63, w = __builtin_amdgcn_readfirstlane(tid >> 6), r16 = lane & 15, q4 = lane >> 4;
    const int sg = item & 7, dir = (item >> 3) & 1, head = (item >> 4) & 7, sq = item >> 7;
    if (PASS == 1 && sg == 7) return;
    const int kcol = tid & 127, qtr = tid >> 7;
    const char* ubq = (const char*)(Pb + OFF_Q + (size_t)sq * SEQ * 1024 + head * 128);
    const char* ubf = (const char*)(Pb + OFF_FF + (size_t)dir * PE1 + (size_t)sq * SEQ * 1024 + head * 128);
    const char* ubv = (const char*)(Pb + OFF_V + (size_t)sq * SEQ * 1024 + head * 128);
    const unsigned voff0 = (unsigned)kcol * 2u + (unsigned)(dir ? 63 - 16 * qtr : 16 * qtr) * 2048u;
    const int vstep = dir ? -2048 : 2048;
    bf16* Od = (dir ? Ob : Of) + (size_t)sq * SEQ * DM + head * 128 + 16 * w + r16;
    f32x4 S[8];
#pragma unroll
    for (int kt = 0; kt < 8; ++kt) S[kt] = (f32x4){0.f, 0.f, 0.f, 0.f};
    if (PASS == 2) {
        for (int s2 = 0; s2 < sg; ++s2) {
            const int it2 = item - sg + s2;
            const float* Lp = segL + (size_t)it2 * 16384 + (size_t)(w * 8) * 256 + lane;
            const float* Dp = segD + (size_t)it2 * 128 + 4 * q4;
#pragma unroll
            for (int kt = 0; kt < 8; ++kt) { const f32x4 d = *(const f32x4*)(Dp + 16 * kt);
#pragma unroll
                for (int i = 0; i < 4; ++i) S[kt][i] = d[i] * S[kt][i] + Lp[(kt * 4 + i) * 64]; }
        }
    }
    float bseg = 0.f;
    LAS float* TOT = (LAS float*)(lds + HG_TOT); LAS float* DL = (LAS float*)(lds + HG_DL);
    unsigned short qv[16], vv[16], lfn[16];
#define HG_LOAD(pp) do { const size_t cb_ = (size_t)(dir ? (SEQ - 64 * ((pp) + 1)) : (64 * (pp))) * 2048;     \
        const char* cq_ = ubq + cb_; const char* cf_ = ubf + cb_; const char* cv_ = ubv + cb_; \
        _Pragma("unroll") for (int i = 0; i < 16; ++i) { const unsigned vo_ = voff0 + (unsigned)(vstep * i); \
            lfn[i] = *(const bf16*)(cf_ + vo_); vv[i] = *(const bf16*)(cv_ + vo_); if (PASS == 2) qv[i] = *(const bf16*)(cq_ + vo_); } } while (0)
    HG_LOAD(sg * 16);
    for (int j = 0; j < 16; ++j) {
        const int p = sg * 16 + j;
        float cs[16]; unsigned short lfr[16];
#pragma unroll
        for (int i = 0; i < 16; ++i) lfr[i] = lfn[i];
        { float run = 0.f;
#pragma unroll
          for (int i = 0; i < 16; ++i) { run += bf2f(lfr[i]); cs[i] = run; } }
        TOT[qtr * 128 + kcol] = cs[15];
        { u32x4 a, b; a.x = vv[0] | ((unsigned)vv[1] << 16); a.y = vv[2] | ((unsigned)vv[3] << 16); a.z = vv[4] | ((unsigned)vv[5] << 16); a.w = vv[6] | ((unsigned)vv[7] << 16);
          b.x = vv[8] | ((unsigned)vv[9] << 16); b.y = vv[10] | ((unsigned)vv[11] << 16); b.z = vv[12] | ((unsigned)vv[13] << 16); b.w = vv[14] | ((unsigned)vv[15] << 16);
          LAS u32x4* vp = (LAS u32x4*)(lds + HG_VT + kcol * 144 + qtr * 32); vp[0] = a; vp[1] = b; }
        __syncthreads();
        const float t0 = TOT[kcol], t1 = TOT[128 + kcol], t2 = TOT[256 + kcol], t3 = TOT[384 + kcol];
        const float off = (qtr > 0 ? t0 : 0.f) + (qtr > 1 ? t1 : 0.f) + (qtr > 2 ? t2 : 0.f);
        const float r1 = t0 + t1, blast = (t0 + t1) + (t2 + t3);
        const float rblk = (qtr >= 2) ? r1 : 0.f;
        if (qtr == 0) { DL[kcol] = ex2(blast * 1.4426950408889634f); bseg += blast; }
        unsigned ks[8];
        constexpr float L2E = 1.4426950408889634f;
        const float er1 = ex2(r1 * L2E), ebl1 = ex2((blast - r1) * L2E);
#pragma unroll
        for (int i = 0; i < 16; i += 2) {
            float kk[2], bb[2], e1[2], e2[2], eks[2], e3[2];
#pragma unroll
            for (int e = 0; e < 2; ++e) {
                bb[e] = off + cs[i + e]; kk[e] = 1.0f - ex2(bf2f(lfr[i + e]) * L2E);
                if (qtr < 2) {
                    e1[e] = ex2(bb[e] * L2E); e2[e] = ex2(fminf(-bb[e], 80.f) * L2E); e3[e] = ex2((r1 - bb[e]) * L2E); eks[e] = e3[e] * ebl1;
                } else {
                    e1[e] = ex2((bb[e] - r1) * L2E); e2[e] = ex2(fminf(r1 - bb[e], 80.f) * L2E); e3[e] = 0.f; eks[e] = ex2((blast - bb[e]) * L2E);
                }
            }
            ks[i >> 1] = cvtpk(kk[0] * eks[0], kk[1] * eks[1]);
            if (PASS == 2) {
                const float q0 = bf2f(qv[i]), q1 = bf2f(qv[i + 1]);
                const int tau = 16 * qtr + i;
                const unsigned wqd = cvtpk(q0 * e1[0], q1 * e1[1]);
                const unsigned wkd = cvtpk(kk[0] * e2[0], kk[1] * e2[1]);
                const unsigned wqs = (qtr < 2) ? wqd : cvtpk(q0 * e1[0] * er1, q1 * e1[1] * er1);
                *(LAS bf16*)(lds + HG_QD + tau * 272 + kcol * 2) = (bf16)(wqd & 0xffffu); *(LAS bf16*)(lds + HG_QD + (tau + 1) * 272 + kcol * 2) = (bf16)(wqd >> 16);
                *(LAS bf16*)(lds + HG_KD + tau * 272 + kcol * 2) = (bf16)(wkd & 0xffffu); *(LAS bf16*)(lds + HG_KD + (tau + 1) * 272 + kcol * 2) = (bf16)(wkd >> 16);
                *(LAS bf16*)(lds + HG_QS + tau * 272 + kcol * 2) = (bf16)(wqs & 0xffffu); *(LAS bf16*)(lds + HG_QS + (tau + 1) * 272 + kcol * 2) = (bf16)(wqs >> 16);
                if (qtr < 2) { const unsigned wk0 = cvtpk(kk[0] * e3[0], kk[1] * e3[1]);
                    *(LAS bf16*)(lds + HG_K0E + tau * 272 + kcol * 2) = (bf16)(wk0 & 0xffffu); *(LAS bf16*)(lds + HG_K0E + (tau + 1) * 272 + kcol * 2) = (bf16)(wk0 >> 16); }
            }
        }
        { LAS u32x4* kp = (LAS u32x4*)(lds + HG_KST + kcol * 144 + qtr * 32); kp[0] = (u32x4){ks[0], ks[1], ks[2], ks[3]}; kp[1] = (u32x4){ks[4], ks[5], ks[6], ks[7]}; }
        __syncthreads();
        if (j + 1 < 16) HG_LOAD(p + 1);
        if (PASS == 2) {
            const int ti = w >> 1;
#pragma unroll
            for (int e = 0; e < 2; ++e) {
                const int sj = 2 * (w & 1) + e;
                f32x4 a4 = (f32x4){0.f, 0.f, 0.f, 0.f};
                if (sj <= ti) {
                    const int bsrc = (ti >= 2 && sj < 2) ? HG_K0E : HG_KD;
                    bf16x8 fa[4], fb[4];
#pragma unroll
                    for (int st = 0; st < 4; ++st) {
                        fa[st] = *(const LAS bf16x8*)(lds + HG_QD + (16 * ti + r16) * 272 + (32 * st + 8 * q4) * 2);
                        fb[st] = *(const LAS bf16x8*)(lds + bsrc + (16 * sj + r16) * 272 + (32 * st + 8 * q4) * 2);
                    }
                    __builtin_amdgcn_sched_barrier(0);
#pragma unroll
                    for (int st = 0; st < 4; ++st) a4 = MFMA16(fa[st], fb[st], a4);
                    __builtin_amdgcn_sched_barrier(0);
                }
#pragma unroll
                for (int i = 0; i < 4; ++i) { const int t = 16 * ti + 4 * q4 + i, s = 16 * sj + r16; *(LAS bf16*)(lds + HG_AM + t * 144 + s * 2) = f2bf(s <= t ? a4[i] : 0.f); }
            }
            __syncthreads();
        }
        bf16x8 bv[2];
#pragma unroll
        for (int st = 0; st < 2; ++st) bv[st] = *(const LAS bf16x8*)(lds + HG_VT + (16 * w + r16) * 144 + (32 * st + 8 * q4) * 2);
        if (PASS == 2) {
            bf16x8 sb[4];
#pragma unroll
            for (int k2 = 0; k2 < 4; ++k2) { u32x4 pz; pz.x = pk2(S[2 * k2][0], S[2 * k2][1]); pz.y = pk2(S[2 * k2][2], S[2 * k2][3]); pz.z = pk2(S[2 * k2 + 1][0], S[2 * k2 + 1][1]); pz.w = pk2(S[2 * k2 + 1][2], S[2 * k2 + 1][3]);
                sb[k2] = __builtin_bit_cast(bf16x8, pz); }
#pragma unroll
            for (int ti = 0; ti < 4; ++ti) {
                f32x4 o4 = (f32x4){0.f, 0.f, 0.f, 0.f};
                bf16x8 fam[2]; s16x4 ql[4], qh[4];
#pragma unroll
                for (int st = 0; st < 2; ++st) fam[st] = *(const LAS bf16x8*)(lds + HG_AM + (16 * ti + r16) * 144 + (32 * st + 8 * q4) * 2);
#pragma unroll
                for (int k2 = 0; k2 < 4; ++k2) {
                    ql[k2] = *(const LAS s16x4*)(lds + HG_QS + (16 * ti + r16) * 272 + (32 * k2 + 4 * q4) * 2);
                    qh[k2] = *(const LAS s16x4*)(lds + HG_QS + (16 * ti + r16) * 272 + (32 * k2 + 16 + 4 * q4) * 2);
                }
                __builtin_amdgcn_sched_barrier(0);
#pragma unroll
                for (int st = 0; st < 2; ++st) o4 = MFMA16(fam[st], bv[st], o4);
#pragma unroll
                for (int k2 = 0; k2 < 4; ++k2) o4 = MFMA16(__builtin_shufflevector(ql[k2], qh[k2], 0, 1, 2, 3, 4, 5, 6, 7), sb[k2], o4);
                __builtin_amdgcn_sched_barrier(0);
#pragma unroll
                for (int i = 0; i < 4; ++i) { const int tau = 16 * ti + 4 * q4 + i; const int tok = dir ? (SEQ - 1 - 64 * p - tau) : (64 * p + tau); Od[(size_t)tok * DM] = f2bf(o4[i]); }
            }
        }
#pragma unroll
        for (int kh = 0; kh < 2; ++kh) {
            bf16x8 fk[4][2]; f32x4 dd[4];
#pragma unroll
            for (int k4 = 0; k4 < 4; ++k4) { const int kt = 4 * kh + k4;
                dd[k4] = *(const LAS f32x4*)(lds + HG_DL + (16 * kt + 4 * q4) * 4);
#pragma unroll
                for (int st = 0; st < 2; ++st) fk[k4][st] = *(const LAS bf16x8*)(lds + HG_KST + (16 * kt + r16) * 144 + (32 * st + 8 * q4) * 2); }
            __builtin_amdgcn_sched_barrier(0);
#pragma unroll
            for (int k4 = 0; k4 < 4; ++k4) { const int kt = 4 * kh + k4; S[kt] = S[kt] * dd[k4]; }
#pragma unroll
            for (int st = 0; st < 2; ++st)
#pragma unroll
                for (int k4 = 0; k4 < 4; ++k4) { const int kt = 4 * kh + k4; S[kt] = MFMA16(fk[k4][st], bv[st], S[kt]); }
            __builtin_amdgcn_sched_barrier(0);
        }
        __syncthreads();
    }
    if (PASS == 1) {
        float* Lp = segL + (size_t)item * 16384 + (size_t)(w * 8) * 256 + lane;
#pragma unroll
        for (int kt = 0; kt < 8; ++kt)
#pragma unroll
            for (int i = 0; i < 4; ++i) Lp[(kt * 4 + i) * 64] = S[kt][i];
        if (qtr == 0) segD[(size_t)item * 128 + kcol] = __expf(bseg);
    }
}

constexpr int DA_K = 0, DA_V = 69632;
typedef short v4i16_t __attribute__((ext_vector_type(4)));
DI s16x4 vtr(LAS unsigned char* p) { return __builtin_bit_cast(s16x4, __builtin_amdgcn_ds_read_tr16_b64_v4i16((LAS v4i16_t*)p)); }
struct DaIdx { int head, g, sq, dil, L, res, m0, qcol; };
DI DaIdx da_index(int item) {
    DaIdx d; const int idx = item & 63; d.head = (item >> 6) & 3; d.g = (item >> 8) % 3; d.sq = (item >> 8) / 3;
    d.dil = (d.g == 0) ? 1 : ((d.g == 1) ? 4 : 16); d.L = SEQ / d.dil; const int tpr = d.L / 128; d.res = idx / tpr; d.m0 = 128 * (idx % tpr);
    d.qcol = 128 * d.head; return d;
}
DI void da_load(const bf16* Pb, int item, int tid, u32x4 (&kreg)[8], u32x4 (&vreg)[8], bf16x8 (&qf)[4]) {
    const DaIdx d = da_index(item);
    const int lane = tid & 63, w = tid >> 6, r16 = lane & 15, q4 = lane >> 4;
    const bf16* rowbase = Pb + OFF_ATT0 + (size_t)(3 * d.g) * PE2 + (size_t)d.sq * SEQ * 512;
    const bf16* qrow = rowbase + (size_t)((d.m0 + 16 * w + r16) * d.dil + d.res) * 512 + d.qcol;
#pragma unroll
    for (int st = 0; st < 4; ++st) qf[st] = *(const bf16x8*)(qrow + 32 * st + 8 * q4);
#pragma unroll
    for (int it = 0; it < 8; ++it) {
        const int e = it * 512 + tid, key = e >> 4, ch = e & 15, m = d.m0 - 64 + key;
        kreg[it] = (u32x4){0u, 0u, 0u, 0u}; vreg[it] = kreg[it];
        if (m >= 0 && m < d.L) { const bf16* rp = rowbase + (size_t)(m * d.dil + d.res) * 512 + d.qcol + ch * 8; kreg[it] = *(const u32x4*)(rp + PE2); vreg[it] = *(const u32x4*)(rp + 2 * PE2); }
    }
}
DI void dattn_items(LAS unsigned char* lds, bf16* Pb, float* lse, int first, int stride, int nitems, int tid) {
    const int lane = tid & 63, w = __builtin_amdgcn_readfirstlane(tid >> 6), r16 = lane & 15, q4 = lane >> 4;
    u32x4 kreg[8], vreg[8]; bf16x8 qn[4];
    if (first < nitems) da_load(Pb, first, tid, kreg, vreg, qn);
    for (int item = first; item < nitems; item += stride) {
    const DaIdx d = da_index(item);
    const int head = d.head, g = d.g, sq = d.sq, dil = d.dil, L = d.L, res = d.res, m0 = d.m0, qcol = d.qcol;
    bf16* rowbase = Pb + OFF_ATT0 + (size_t)(3 * g) * PE2 + (size_t)sq * SEQ * 512;
    const int mq = m0 + 16 * w + r16;
    bf16* qrow = rowbase + (size_t)(mq * dil + res) * 512 + qcol;
    bf16x8 qf[4];
#pragma unroll
    for (int st = 0; st < 4; ++st) qf[st] = qn[st];
#pragma unroll
    for (int it = 0; it < 8; ++it) {
        const int e = it * 512 + tid, key = e >> 4, ch = e & 15;
        *(LAS u32x4*)(lds + DA_K + key * 272 + ch * 16) = kreg[it];
        *(LAS u32x4*)(lds + DA_V + key * 288 + ch * 16) = vreg[it];
    }
    __syncthreads();
    if (item + stride < nitems) da_load(Pb, item + stride, tid, kreg, vreg, qn);
    f32x4 sc[9];
    float mx = -1e30f;
#pragma unroll
    for (int kt = 0; kt < 9; ++kt) {
        f32x4 a4 = (f32x4){0.f, 0.f, 0.f, 0.f};
        bf16x8 fa[4];
#pragma unroll
        for (int st = 0; st < 4; ++st) fa[st] = *(const LAS bf16x8*)(lds + DA_K + (16 * w + 16 * kt + r16) * 272 + (32 * st + 8 * q4) * 2);
        __builtin_amdgcn_sched_barrier(0);
#pragma unroll
        for (int st = 0; st < 4; ++st) a4 = MFMA16(fa[st], qf[st], a4);
        __builtin_amdgcn_sched_barrier(0);
#pragma unroll
        for (int i = 0; i < 4; ++i) { const int mk = m0 - 64 + 16 * w + 16 * kt + 4 * q4 + i; const int dd = mk - mq;
            const bool ok = (mk >= 0) && (mk < L) && (dd <= 64) && (dd >= -64); a4[i] = ok ? a4[i] : -1e30f; mx = fmaxf(mx, a4[i]); }
        sc[kt] = a4;
    }
    mx = fmaxf(mx, __shfl_xor(mx, 16)); mx = fmaxf(mx, __shfl_xor(mx, 32));
    float sum = 0.f;
#pragma unroll
    for (int kt = 0; kt < 9; ++kt)
#pragma unroll
        for (int i = 0; i < 4; ++i) { const float pv = __builtin_amdgcn_exp2f(sc[kt][i] - mx); sc[kt][i] = pv; sum += pv; }
    sum += __shfl_xor(sum, 16); sum += __shfl_xor(sum, 32);
    bf16x8 pb[5];
#pragma unroll
    for (int pp = 0; pp < 5; ++pp) { u32x4 pz; pz.x = pk2(sc[2 * pp][0], sc[2 * pp][1]); pz.y = pk2(sc[2 * pp][2], sc[2 * pp][3]);
        if (pp < 4) { pz.z = pk2(sc[2 * pp + 1][0], sc[2 * pp + 1][1]); pz.w = pk2(sc[2 * pp + 1][2], sc[2 * pp + 1][3]); } else { pz.z = 0u; pz.w = 0u; }
        pb[pp] = __builtin_bit_cast(bf16x8, pz); }
    const float rs = 1.0f / sum;
#pragma unroll
    for (int dt = 0; dt < 8; ++dt) {
        f32x4 o4 = (f32x4){0.f, 0.f, 0.f, 0.f};
        s16x4 vl[5], vh[5];
#pragma unroll
        for (int pp = 0; pp < 5; ++pp) {
            LAS unsigned char* vb = lds + DA_V + (16 * w + 32 * pp + 4 * q4 + (r16 >> 2)) * 288 + (16 * dt + 4 * (r16 & 3)) * 2;
            vl[pp] = vtr(vb);
            vh[pp] = vtr(pp < 4 ? vb + 16 * 288 : vb);
        }
        __builtin_amdgcn_sched_barrier(0);
#pragma unroll
        for (int pp = 0; pp < 5; ++pp) o4 = MFMA16(__builtin_shufflevector(vl[pp], vh[pp], 0, 1, 2, 3, 4, 5, 6, 7), pb[pp], o4);
        __builtin_amdgcn_sched_barrier(0);
        u32x2 wv; wv.x = pk2(o4[0] * rs, o4[1] * rs); wv.y = pk2(o4[2] * rs, o4[3] * rs);
        *(u32x2*)(qrow + 16 * dt + 4 * q4) = wv;
    }
    if (q4 == 0) lse[((size_t)sq * SEQ + (size_t)(mq * dil + res)) * 12 + g * 4 + head] = mx + __builtin_amdgcn_logf(sum);
    __syncthreads();
    }
}

DI void xattn_item(LAS unsigned char* lds, bf16* Qx, const bf16* Kmem, const bf16* Vtmem, int b, int item, int tid) {
    const int lane = tid & 63, w = __builtin_amdgcn_readfirstlane(tid >> 6), r16 = lane & 15, q4 = lane >> 4;
    const int qt = item & 63, head = (item >> 6) & 3, sq = item >> 8, mseq = 2 * b + sq;
    const bf16* Kg = Kmem + (size_t)mseq * 256 * 1024 + head * 256;
    const bf16* Vg = Vtmem + (size_t)(mseq * 4 + head) * 256 * 256;
    bf16* qrow = Qx + ((size_t)sq * SEQ + 128 * qt + 16 * w + r16) * DM + head * 256;
    bf16x8 qf[8];
#pragma unroll
    for (int st = 0; st < 8; ++st) qf[st] = *(const bf16x8*)(qrow + 32 * st + 8 * q4);
    {
        u32x4 kreg[16];
#pragma unroll
        for (int it = 0; it < 16; ++it) { const int e = it * 512 + tid, key = e >> 5, ch = e & 31; kreg[it] = *(const u32x4*)(Kg + (size_t)key * 1024 + ch * 8); }
#pragma unroll
        for (int it = 0; it < 16; ++it) { const int e = it * 512 + tid, key = e >> 5, ch = e & 31; *(LAS u32x4*)(lds + key * 528 + ch * 16) = kreg[it]; }
    }
    __syncthreads();
    f32x4 sc[16]; float mx = -1e30f;
#define XA_KREAD(dst, kt_) _Pragma("unroll") for (int st = 0; st < 8; ++st) dst[st] = *(const LAS bf16x8*)(lds + (16 * (kt_) + r16) * 528 + (32 * st + 8 * q4) * 2)
#define XA_TILE(src, kt_) do { f32x4 a4 = (f32x4){0.f, 0.f, 0.f, 0.f}; _Pragma("unroll") for (int st = 0; st < 8; ++st) a4 = MFMA16(src[st], qf[st], a4); \
        _Pragma("unroll") for (int i = 0; i < 4; ++i) mx = fmaxf(mx, a4[i]); sc[kt_] = a4; } while (0)
    {
#pragma unroll
        for (int kt = 0; kt < 16; ++kt) {
            bf16x8 fa[8];
            XA_KREAD(fa, kt); __builtin_amdgcn_sched_barrier(0);
            XA_TILE(fa, kt); __builtin_amdgcn_sched_barrier(0);
        }
    }
    mx = fmaxf(mx, __shfl_xor(mx, 16)); mx = fmaxf(mx, __shfl_xor(mx, 32));
    float sum = 0.f;
#pragma unroll
    for (int kt = 0; kt < 16; ++kt)
#pragma unroll
        for (int i = 0; i < 4; ++i) { const float pv = __builtin_amdgcn_exp2f(sc[kt][i] - mx); sc[kt][i] = pv; sum += pv; }
    sum += __shfl_xor(sum, 16); sum += __shfl_xor(sum, 32);
    bf16x8 pb[8];
#pragma unroll
    for (int pp = 0; pp < 8; ++pp) { u32x4 pz; pz.x = pk2(sc[2 * pp][0], sc[2 * pp][1]); pz.y = pk2(sc[2 * pp][2], sc[2 * pp][3]); pz.z = pk2(sc[2 * pp + 1][0], sc[2 * pp + 1][1]); pz.w = pk2(sc[2 * pp + 1][2], sc[2 * pp + 1][3]);
        pb[pp] = __builtin_bit_cast(bf16x8, pz); }
    {
        u32x4 vreg[16];
#pragma unroll
        for (int it = 0; it < 16; ++it) { const int e = it * 512 + tid, d = e >> 5, ch = e & 31; vreg[it] = *(const u32x4*)(Vg + (size_t)d * 256 + ch * 8); }
        __syncthreads();
#pragma unroll
        for (int it = 0; it < 16; ++it) { const int e = it * 512 + tid, d = e >> 5, ch = e & 31; *(LAS u32x4*)(lds + d * 528 + ch * 16) = vreg[it]; }
    }
    __syncthreads();
    const float rs = __builtin_amdgcn_rcpf(sum);
#define XA_VREAD(dst, dt_) _Pragma("unroll") for (int pp = 0; pp < 8; ++pp) { dst[2 * pp] = *(const LAS s16x4*)(lds + (16 * (dt_) + r16) * 528 + (32 * pp + 4 * q4) * 2); \
        dst[2 * pp + 1] = *(const LAS s16x4*)(lds + (16 * (dt_) + r16) * 528 + (32 * pp + 16 + 4 * q4) * 2); }
#define XA_OTILE(src, dt_) do { f32x4 o4 = (f32x4){0.f, 0.f, 0.f, 0.f}; _Pragma("unroll") for (int pp = 0; pp < 8; ++pp) o4 = MFMA16(__builtin_shufflevector(src[2 * pp], src[2 * pp + 1], 0, 1, 2, 3, 4, 5, 6, 7), pb[pp], o4); \
        u32x2 wv; wv.x = cvtpk(o4[0] * rs, o4[1] * rs); wv.y = cvtpk(o4[2] * rs, o4[3] * rs); *(u32x2*)(qrow + 16 * (dt_) + 4 * q4) = wv; } while (0)
    {
#pragma unroll
        for (int dt = 0; dt < 16; ++dt) {
            s16x4 va[16];
            XA_VREAD(va, dt); __builtin_amdgcn_sched_barrier(0);
            XA_OTILE(va, dt); __builtin_amdgcn_sched_barrier(0);
        }
    }
    __syncthreads();
}

DI void post_row(bf16* P, int m, const bf16* ofr, const bf16* obr, const float* lser, const float* gn, bf16* Urow, int lane) {
    bf16* arow = P + OFF_ATT0 + (size_t)m * 512 + 8 * lane; const bf16* grow = P + OFF_G + (size_t)m * 1024;
    { const int h = lane >> 4; const float l0 = lser[h], l1 = lser[4 + h], l2 = lser[8 + h]; const float mxl = fmaxf(l0, fmaxf(l1, l2));
      float w0 = __builtin_amdgcn_exp2f(l0 - mxl), w1 = __builtin_amdgcn_exp2f(l1 - mxl), w2 = __builtin_amdgcn_exp2f(l2 - mxl); const float rs = 1.0f / (w0 + w1 + w2); w0 *= rs; w1 *= rs; w2 *= rs;
      const u32x4 a = *(const u32x4*)arow, b = *(const u32x4*)(arow + 3 * PE2), c = *(const u32x4*)(arow + 6 * PE2);
      u32x4 o;
      o.x = pk2(w0 * lo_f(a.x) + w1 * lo_f(b.x) + w2 * lo_f(c.x), w0 * hi_f(a.x) + w1 * hi_f(b.x) + w2 * hi_f(c.x));
      o.y = pk2(w0 * lo_f(a.y) + w1 * lo_f(b.y) + w2 * lo_f(c.y), w0 * hi_f(a.y) + w1 * hi_f(b.y) + w2 * hi_f(c.y));
      o.z = pk2(w0 * lo_f(a.z) + w1 * lo_f(b.z) + w2 * lo_f(c.z), w0 * hi_f(a.z) + w1 * hi_f(b.z) + w2 * hi_f(c.z));
      o.w = pk2(w0 * lo_f(a.w) + w1 * lo_f(b.w) + w2 * lo_f(c.w), w0 * hi_f(a.w) + w1 * hi_f(b.w) + w2 * hi_f(c.w));
      *(u32x4*)arow = o; }
    { float o[16];
#pragma unroll
      for (int hlf = 0; hlf < 2; ++hlf) { const u32x4 a = *(const u32x4*)(ofr + 16 * lane + 8 * hlf), b = *(const u32x4*)(obr + 16 * lane + 8 * hlf);
          o[8 * hlf + 0] = lo_f(a.x) + lo_f(b.x); o[8 * hlf + 1] = hi_f(a.x) + hi_f(b.x); o[8 * hlf + 2] = lo_f(a.y) + lo_f(b.y); o[8 * hlf + 3] = hi_f(a.y) + hi_f(b.y);
          o[8 * hlf + 4] = lo_f(a.z) + lo_f(b.z); o[8 * hlf + 5] = hi_f(a.z) + hi_f(b.z); o[8 * hlf + 6] = lo_f(a.w) + lo_f(b.w); o[8 * hlf + 7] = hi_f(a.w) + hi_f(b.w); }
      float ss = 0.f;
#pragma unroll
      for (int i = 0; i < 16; ++i) ss += o[i] * o[i];
      ss += __shfl_xor(ss, 1); ss += __shfl_xor(ss, 2); ss += __shfl_xor(ss, 4);
      const float rstd = rsqrtf(ss * (1.0f / 128.0f) + RMS_EPS);
      const int vc = (16 * lane) & 127;
#pragma unroll
      for (int hlf = 0; hlf < 2; ++hlf) { const u32x4 gsl = *(const u32x4*)(grow + 16 * lane + 8 * hlf);
          const f32x4 g0 = *(const f32x4*)(gn + vc + 8 * hlf), g1 = *(const f32x4*)(gn + vc + 8 * hlf + 4);
          u32x4 wv;
          wv.x = pk2(o[8 * hlf + 0] * rstd * g0[0] * lo_f(gsl.x), o[8 * hlf + 1] * rstd * g0[1] * hi_f(gsl.x));
          wv.y = pk2(o[8 * hlf + 2] * rstd * g0[2] * lo_f(gsl.y), o[8 * hlf + 3] * rstd * g0[3] * hi_f(gsl.y));
          wv.z = pk2(o[8 * hlf + 4] * rstd * g1[0] * lo_f(gsl.z), o[8 * hlf + 5] * rstd * g1[1] * hi_f(gsl.z));
          wv.w = pk2(o[8 * hlf + 6] * rstd * g1[2] * lo_f(gsl.w), o[8 * hlf + 7] * rstd * g1[3] * hi_f(gsl.w));
          *(u32x4*)(Urow + 16 * lane + 8 * hlf) = wv; } }
}

#define XB_TMO      128
#define XB_XCNT(j)  (256  + 64 * (j))
#define XB_XSUB(j)  (1280 + 64 * (j))
#define XB_XGEN(j)  (2304 + 64 * (j))
#define XB_TOP      3328
#define XB_TOPGEN   3392
#define XCD_BAR_WORDS 3456
#define XB_SPIN_CAP (1u << 18)
DI unsigned xb_ld(unsigned* p)              { return __hip_atomic_load(p, __ATOMIC_RELAXED, __HIP_MEMORY_SCOPE_AGENT); }
DI unsigned xb_add(unsigned* p, unsigned v) { return __hip_atomic_fetch_add(p, v, __ATOMIC_RELAXED, __HIP_MEMORY_SCOPE_AGENT); }
DI unsigned xb_xcc_id() { return (unsigned)__builtin_amdgcn_s_getreg((3 << 11) | 20) & 0xFu; }
#define XB_SPIN(cond, bar) do { unsigned _sp = 0; while (cond) { __builtin_amdgcn_s_sleep(1); \
    if ((++_sp & 255u) == 0u) { if (xb_ld(&(bar)[XB_TMO])) break; if (_sp > XB_SPIN_CAP) { atomicAdd(&(bar)[XB_TMO], 1u); break; } } } } while (0)
struct XcdBarrier { unsigned* bar; unsigned x; volatile LAS unsigned* st; };
DI XcdBarrier xcd_barrier_post(unsigned* bar, volatile LAS unsigned* st) {
    XcdBarrier b; b.bar = bar; b.x = xb_xcc_id(); b.st = st;
    if (threadIdx.x == 0) (void)xb_add(&bar[XB_XCNT(b.x)], 1u);
    return b;
}
DI void xcd_barrier_complete(unsigned* bar, unsigned x, unsigned& nloc, unsigned& nx) {
    const unsigned G = gridDim.x * gridDim.y * gridDim.z;
    unsigned sum, cnt, mine, sp = 0u;
    for (;;) {
        sum = 0u; cnt = 0u; mine = 0u;
#pragma unroll
        for (unsigned j = 0; j < 16; ++j) { const unsigned c = xb_ld(&bar[XB_XCNT(j)]); sum += c; cnt += (c > 0u) ? 1u : 0u; mine = (j == x) ? c : mine; }
        if (sum == G) break;
        __builtin_amdgcn_s_sleep(1);
        if ((++sp & 255u) == 0u) { if (xb_ld(&bar[XB_TMO])) break; if (sp > XB_SPIN_CAP) { atomicAdd(&bar[XB_TMO], 1u); break; } }
    }
    nloc = mine > 0u ? mine : 1u; nx = cnt > 0u ? cnt : 1u;
}
DI void xcd_barrier(const XcdBarrier& b) {
    asm volatile("s_waitcnt vmcnt(0)" ::: "memory");
    __syncthreads();
    if (threadIdx.x == 0) {
        unsigned* bar = b.bar;
        __builtin_amdgcn_s_waitcnt(0);
        unsigned nloc = b.st[0], nx = b.st[1];
        if (nloc == 0u) { xcd_barrier_complete(bar, b.x, nloc, nx); b.st[0] = nloc; b.st[1] = nx; }
        const unsigned old = xb_add(&bar[XB_XSUB(b.x)], 1u);
        const unsigned gen = old / nloc;
        if (old + 1u == (gen + 1u) * nloc) {
            __builtin_amdgcn_fence(__ATOMIC_RELEASE, "agent");
            asm volatile("s_waitcnt vmcnt(0)" ::: "memory");
            const unsigned og = xb_add(&bar[XB_TOP], 1u);
            const unsigned tg = og / nx;
            if (og + 1u == (tg + 1u) * nx) xb_add(&bar[XB_TOPGEN], 1u);
            else XB_SPIN(xb_ld(&bar[XB_TOPGEN]) == tg, bar);
            __builtin_amdgcn_fence(__ATOMIC_ACQUIRE, "agent");
            xb_add(&bar[XB_XGEN(b.x)], 1u);
            asm volatile("s_waitcnt vmcnt(0)" ::: "memory");
        } else {
            XB_SPIN(xb_ld(&bar[XB_XGEN(b.x)]) == gen, bar);
            __builtin_amdgcn_fence(__ATOMIC_ACQUIRE, "agent");
            asm volatile("s_waitcnt vmcnt(0)" ::: "memory");
        }
    }
    __syncthreads();
}

struct Args { const float* in[20]; float* out; unsigned char* ws; int ph_lo, ph_hi; };
constexpr int NPB = 12;
constexpr int NPH = 1 + NBATCH * NPB;

__global__ void __launch_bounds__(512, 2) fwd_kernel(Args args) {
    extern __shared__ __attribute__((aligned(16))) unsigned char lds_raw[];
    LAS unsigned char* lds = (LAS unsigned char*)lds_raw;
    const int G = gridDim.x, bx = blockIdx.x;
    const int NGW = G * 8;
    const int wave = __builtin_amdgcn_readfirstlane((int)threadIdx.x >> 6), gw = bx * 8 + wave;
    unsigned char* ws = args.ws;
    const float* x_prompt = args.in[0]; const float* x_sample = args.in[1];
    bf16* W_in = (bf16*)(ws + WS_WIN); bf16* W_ho = (bf16*)(ws + WS_WHO); bf16* W_ao = (bf16*)(ws + WS_WAO); bf16* W_out = (bf16*)(ws + WS_WOUT);
    bf16* W_xq = (bf16*)(ws + WS_WXQ); bf16* W_xkv = (bf16*)(ws + WS_WXKV); bf16* W_xo = (bf16*)(ws + WS_WXO); bf16* W_f1 = (bf16*)(ws + WS_WF1); bf16* W_f2 = (bf16*)(ws + WS_WF2);
    float* LB = (float*)(ws + WS_LB); float* ROPE = (float*)(ws + WS_ROPE); float* SEGD = (float*)(ws + WS_SEGD); float* SEGL = (float*)(ws + WS_SEGL);
    bf16* MEMN = (bf16*)(ws + WS_MEMN); bf16* KMEM = (bf16*)(ws + WS_KMEM); bf16* VTMEM = (bf16*)(ws + WS_VTMEM); float* LSE = (float*)(ws + WS_LSE);
    bf16* U = (bf16*)(ws + WS_U); bf16* P = (bf16*)(ws + WS_P); float* SS = (float*)(ws + WS_SS);
    cg::grid_group grid = cg::this_grid();
    if (threadIdx.x < 2) *(volatile LAS unsigned*)(lds + LDS_BARST + 4 * threadIdx.x) = 0u;
    __syncthreads();
    XcdBarrier xbar = xcd_barrier_post((unsigned*)(ws + WS_CTL), (volatile LAS unsigned*)(lds + LDS_BARST));

    for (int ph = args.ph_lo; ph < args.ph_hi; ++ph) {
#define TID_INIT unsigned ones_ = ~0u; asm volatile("" : "+s"(ones_)); int tid = wave * 64 + (int)__builtin_amdgcn_mbcnt_hi(ones_, __builtin_amdgcn_mbcnt_lo(ones_, 0u)); asm volatile("" : "+v"(tid)); const int lane = tid & 63; (void)lane;
        if (ph == 0) {
            TID_INIT
            LAS float* scr = (LAS float*)(lds + wave * 16384);
            constexpr int I_IN = 16 * (NIN / 32), I_HO = 16 * 32, I_AO = 8 * 32, I_OUT = 16 * 32, I_XQ = 16 * 32, I_XKV = 16 * 64, I_XO = 16 * 32, I_F1 = 16 * 128, I_F2 = 64 * 32;
            constexpr int NITEMS = I_IN + I_HO + I_AO + I_OUT + I_XQ + I_XKV + I_XO + I_F1 + I_F2;
            for (int it = gw; it < NITEMS; it += NGW) {
                int r = it;
                if (r < I_IN) { p0_transpose_item(args.in[5], 1024, NIN, W_in, args.in[4], scr, r, lane); continue; } r -= I_IN;
                if (r < I_HO) { p0_transpose_item(args.in[8], 1024, 1024, W_ho, nullptr, scr, r, lane); continue; } r -= I_HO;
                if (r < I_AO) { p0_transpose_item(args.in[9], 512, 1024, W_ao, nullptr, scr, r, lane); continue; } r -= I_AO;
                if (r < I_OUT) { p0_transpose_item(args.in[10], 1024, 1024, W_out, nullptr, scr, r, lane); continue; } r -= I_OUT;
                if (r < I_XQ) { p0_transpose_item(args.in[13], 1024, 1024, W_xq, args.in[11], scr, r, lane); continue; } r -= I_XQ;
                if (r < I_XKV) { p0_transpose_item(args.in[14], 1024, 2048, W_xkv, args.in[12], scr, r, lane); continue; } r -= I_XKV;
                if (r < I_XO) { p0_transpose_item(args.in[15], 1024, 1024, W_xo, nullptr, scr, r, lane); continue; } r -= I_XO;
                if (r < I_F1) { p0_transpose_item(args.in[17], 1024, FF, W_f1, args.in[16], scr, r, lane); continue; } r -= I_F1;
                p0_transpose_item(args.in[18], FF, 1024, W_f2, nullptr, scr, r, lane);
            }
            const int gt = bx * 512 + tid, NGT = G * 512;
            for (int i = gt; i < 2048; i += NGT) { const int d = i >> 10, f = i & 1023; const float l0 = args.in[6][d * 2048 + f], l1 = args.in[6][d * 2048 + 1024 + f]; LB[i] = 1.0f / (1.0f + __expf(l1 - l0)); }
            for (int i = gt; i < SEQ * 16; i += NGT) {
                const int pos = i >> 4, fi = i & 15;
                const float invt[16] = {1.0f, 0.44036659598350525f, 0.1939227432012558f, 0.08539710193872452f, 0.03760603070259094f, 0.016560440883040428f, 0.007292664609849453f, 0.0032114461064338684f,
                                        0.0014142135623842478f, 0.0006227724370546639f, 0.00027424818836152554f, 0.00012076973507646471f, 5.3182957344688475e-05f, 2.34199997066753e-05f, 1.0313385246263351e-05f, 4.541670477919979e-06f};
                float inv = invt[0];
#pragma unroll
                for (int k = 1; k < 16; ++k) inv = (fi == k) ? invt[k] : inv;
                const float x = (float)pos * inv;
                const float kq = rintf(x * 0.63661977236758134308f);
                float r = fmaf(-kq, 1.5707855225e+00f, x); r = fmaf(-kq, 1.0804273188e-05f, r); r = fmaf(-kq, 6.0770999344e-11f, r);
                const float r2 = r * r;
                const float sn = r + r * r2 * (-1.0f / 6 + r2 * (1.0f / 120 + r2 * (-1.0f / 5040 + r2 * (1.0f / 362880))));
                const float cn = 1.0f + r2 * (-0.5f + r2 * (1.0f / 24 + r2 * (-1.0f / 720 + r2 * (1.0f / 40320 + r2 * (-1.0f / 3628800)))));
                const int qd = ((int)kq) & 3;
                const float c = (qd == 0) ? cn : (qd == 1) ? -sn : (qd == 2) ? -cn : sn;
                const float s = (qd == 0) ? sn : (qd == 1) ? cn : (qd == 2) ? -sn : -cn;
                ROPE[2 * i] = c; ROPE[2 * i + 1] = s;
            }
            for (int m = gw; m < NSEQ * NMEM; m += NGW) { const float* src = (m < 512) ? args.in[2] + (size_t)m * DM : args.in[3] + (size_t)(m - 512) * DM; norm_row_bf16(src, MEMN + (size_t)m * DM, lane); }
            for (int m = gw; m < BROWS; m += NGW) norm_row_bf16(x_prompt + (size_t)m * DM, U + (size_t)m * DM, lane);
        } else {
            const int b = (ph - 1) / NPB, pp = (ph - 1) % NPB + 1; const int j = pp + (pp >= 7 ? 1 : 0) + (pp >= 10 ? 1 : 0); const bool rep2 = false;
            const float* xb = (b == 0) ? x_prompt : x_sample + (size_t)(b - 1) * BROWS * DM;
            float* hb = args.out + (size_t)b * BROWS * DM;
            bf16* Of = (bf16*)hb; bf16* Ob = Of + (size_t)BROWS * DM;
            if (j == 1) {
                TID_INIT
                { pg8::Gemm g{U, W_in, BROWS, NIN, DM, DM}; pg8::StaticOrder S; S.init(BROWS, NIN, G, bx); pg8::EpiIn E{P, LB, ROPE};
                  pg8::gemm_phase<pg8::EpiIn, true>(lds, g, S, E, tid); }
                if (b == 0) { pg8::Gemm g{MEMN, W_xkv, NSEQ * NMEM, 2048, DM, DM}; pg8::StaticOrder S; S.init(NSEQ * NMEM, 2048, G, (bx + G / 2) % G); pg8::EpiKV E{KMEM, VTMEM};
                  pg8::gemm_phase<pg8::EpiKV, true>(lds, g, S, E, tid); }
            } else if (j == 2) {
                TID_INIT
                for (int it = bx; it < 256; it += G) hgrn_item<1>(lds, P, Of, Ob, SEGL, SEGD, it, tid);
                { const int vcu = (G % 8 == 0) ? (bx % 8) * (G / 8) + bx / 8 : bx;
                  dattn_items(lds, P, LSE, vcu, G, 1536, tid); }
            } else if (j == 3) {
                TID_INIT
                for (int it = bx; it < 256; it += G) hgrn_item<2>(lds, P, Of, Ob, SEGL, SEGD, it, tid);
            } else if (j == 4) {
                TID_INIT
                for (int m = gw; m < BROWS; m += NGW) post_row(P, m, Of + (size_t)m * DM, Ob + (size_t)m * DM, LSE + (size_t)m * 12, args.in[7], U + (size_t)m * DM, lane);
            } else if (j == 5) {
                TID_INIT
                { pg8::Gemm g{U, W_ho, BROWS, DM, DM, DM}; pg8::StaticOrder S; S.init(BROWS, DM, G, bx); pg8::EpiY<1> E{P}; pg8::gemm_phase<pg8::EpiY<1>, true>(lds, g, S, E, tid); }
                { pg8::Gemm g{P + OFF_ATT0, W_ao, BROWS, DM, 512, 512}; pg8::StaticOrder S; S.init(BROWS, DM, G, bx); pg8::EpiY<2> E{P}; pg8::gemm_phase<pg8::EpiY<2>, true>(lds, g, S, E, tid); }
            } else if (j == 6 || j == 10 || j == 13) {
                TID_INIT
                pg8::StaticOrder S; S.init(BROWS, DM, G, bx);
                if (j == 6) { pg8::Gemm g{P + OFF_GH, W_out, BROWS, DM, DM, 1024}; pg8::EpiRes<0> E{xb, nullptr, U, SS}; pg8::gemm_phase<pg8::EpiRes<0>, true>(lds, g, S, E, tid); }
                else if (j == 10) { pg8::Gemm g{P, W_xo, BROWS, DM, DM, DM}; pg8::EpiRes<1> E{nullptr, nullptr, U, SS + (size_t)BROWS * 16}; pg8::gemm_phase<pg8::EpiRes<1>, true>(lds, g, S, E, tid); }
                else { pg8::Gemm g{P, W_f2, BROWS, DM, FF, FF}; pg8::EpiRes<2> E{nullptr, hb, U, SS + (size_t)2 * BROWS * 16}; pg8::gemm_phase<pg8::EpiRes<2>, true>(lds, g, S, E, tid); }
            } else if (j == 7 || j == 11) {
                TID_INIT
                for (int m = gw; m < BROWS; m += NGW) norm_row_bf16(hb + (size_t)m * DM, U + (size_t)m * DM, lane);
            } else if (j == 8) {
                TID_INIT
                pg8::Gemm g{U, W_xq, BROWS, DM, DM, DM}; pg8::StaticOrder S; S.init(BROWS, DM, G, bx); pg8::EpiBf<0> E{P, DM, QSCALE_X, SS}; pg8::gemm_phase<pg8::EpiBf<0>, true>(lds, g, S, E, tid);
            } else if (j == 9) {
                TID_INIT
                for (int it = bx; it < 512; it += G) xattn_item(lds, P, KMEM, VTMEM, b, it, tid);
            } else if (j == 12) {
                TID_INIT
                pg8::Gemm g{U, W_f1, BROWS, FF, DM, DM}; pg8::StaticOrder S; S.init(BROWS, FF, G, bx); pg8::EpiBf<1> E{P, FF, 1.0f, SS + (size_t)BROWS * 16}; pg8::gemm_phase<pg8::EpiBf<1>, true>(lds, g, S, E, tid);
            } else {
                TID_INIT
                for (int m = gw; m < BROWS; m += NGW) final_row_ss(hb + (size_t)m * DM, args.in[19], SS + ((size_t)2 * BROWS + m) * 16, lane);
                if (b + 1 < NBATCH) { const float* xn = x_sample + (size_t)b * BROWS * DM; for (int m = gw; m < BROWS; m += NGW) norm_row_bf16(xn + (size_t)m * DM, U + (size_t)m * DM, lane); }
            }
        }
        if (ph + 1 < args.ph_hi) { if (ph == 0) { __threadfence(); grid.sync(); } else xcd_barrier(xbar); }
        else __syncthreads();
    }
}

extern "C" void kernel_launch(void* const* d_in, const int* in_sizes, int n_in, void* d_out, int out_size, void* d_ws, size_t ws_size, hipStream_t stream) {
    static int grid = 0;
    if (grid == 0) {
        if (n_in != 20 || ws_size < WS_END) { fprintf(stderr, "kernel_launch: unexpected n_in %d / ws_size %zu\n", n_in, ws_size); grid = -1; return; }
        int dev = 0, cus = 0, per_cu = 0;
        hipGetDevice(&dev); hipDeviceGetAttribute(&cus, hipDeviceAttributeMultiprocessorCount, dev);
        if (hipFuncSetAttribute((const void*)fwd_kernel, hipFuncAttributeMaxDynamicSharedMemorySize, LDS_BYTES) != hipSuccess) { fprintf(stderr, "kernel_launch: hipFuncSetAttribute failed\n"); grid = -1; return; }
        hipOccupancyMaxActiveBlocksPerMultiprocessor(&per_cu, (const void*)fwd_kernel, 512, LDS_BYTES);
        (void)hipGetLastError();
        if (per_cu < 1) per_cu = 1;
        grid = cus;
        fprintf(stderr, "kernel_launch: cus %d per_cu %d grid %d\n", cus, per_cu, grid);
    }
    if (grid < 0) return;
    Args a{};
    for (int i = 0; i < 20; ++i) a.in[i] = (const float*)d_in[i];
    a.out = (float*)d_out; a.ws = (unsigned char*)d_ws;
#if ONE_LAUNCH
    if (hipMemsetAsync((char*)d_ws + WS_CTL, 0, CTL_BYTES, stream) != hipSuccess) { fprintf(stderr, "kernel_launch: memset failed\n"); return; }
    a.ph_lo = 0; a.ph_hi = NPH;
    void* kargs[] = {&a};
    hipError_t e = hipLaunchCooperativeKernel((const void*)fwd_kernel, dim3(grid), dim3(512), kargs, LDS_BYTES, stream);
    if (e != hipSuccess) fprintf(stderr, "cooperative launch failed: %s (grid %d)\n", hipGetErrorString(e), grid);
#else
    for (int ph = 0; ph < NPH; ++ph) {
        a.ph_lo = ph; a.ph_hi = ph + 1;
        hipLaunchKernelGGL(fwd_kernel, dim3(grid), dim3(512), LDS_BYTES, stream, a);
    }
#endif
}
```

```cpp
#include <hip/hip_runtime.h>
#include <hip/hip_cooperative_groups.h>
#include <cstdio>
#include <cstdint>
namespace cg = cooperative_groups;

#ifndef DBL
#define DBL 0
#endif
#ifndef ONE_LAUNCH
#define ONE_LAUNCH 1
#endif

#define DI __device__ __forceinline__
#define LAS __attribute__((address_space(3)))
typedef unsigned short bf16;
typedef short bf16x8 __attribute__((ext_vector_type(8)));
typedef short s16x4 __attribute__((ext_vector_type(4)));
typedef float f32x4 __attribute__((ext_vector_type(4)));
typedef float f32x2 __attribute__((ext_vector_type(2)));
typedef unsigned u32x4 __attribute__((ext_vector_type(4)));
typedef unsigned u32x2 __attribute__((ext_vector_type(2)));

constexpr int DM = 1024, SEQ = 8192, NSEQ = 6, TTOK = NSEQ * SEQ, BROWS = 2 * SEQ  , NBATCH = 3;
constexpr int NIN = 11776, FF = 4096, NMEM = 256;
constexpr int C_Q = 0, C_FF = 1024, C_FB = 2048, C_V = 3072, C_G = 4096, C_ATT = 5120, C_GH = 9728, C_GA = 10752;
constexpr size_t PE1 = (size_t)BROWS * 1024, PE2 = (size_t)BROWS * 512;
constexpr size_t OFF_Q = 0, OFF_FF = PE1, OFF_V = 3 * PE1, OFF_G = 4 * PE1, OFF_ATT0 = 5 * PE1, OFF_GH = 5 * PE1 + 9 * PE2, OFF_GA = OFF_GH + PE1;
constexpr float RMS_EPS = 1e-6f;
constexpr float QSCALE_A = 0.08838834764831845f * 1.4426950408889634f;
constexpr float QSCALE_X = 0.0625f * 1.4426950408889634f;

constexpr size_t MiB = 1u << 20;
constexpr int LDS_BYTES_ = 147456, LDS_BYTES = LDS_BYTES_;
constexpr size_t WS_WIN = 0, WS_WHO = 23 * MiB, WS_WAO = 25 * MiB, WS_WOUT = 26 * MiB, WS_WXQ = 28 * MiB, WS_WXKV = 30 * MiB, WS_WXO = 34 * MiB,
                 WS_WF1 = 36 * MiB, WS_WF2 = 44 * MiB;
constexpr size_t WS_LB = 52 * MiB, WS_ROPE = 52 * MiB + 65536, WS_SEGD = 53 * MiB + 524288, WS_MEMN = 54 * MiB, WS_KMEM = 57 * MiB, WS_VTMEM = 60 * MiB,
                 WS_LSE = 63 * MiB, WS_SEGL = 64 * MiB, WS_U = 80 * MiB, WS_P = 112 * MiB, WS_CTL = 480 * MiB, WS_END = 485 * MiB;
constexpr size_t CTL_BYTES = 16384;
constexpr size_t WS_SS = 481 * MiB;
constexpr int LDS_BARST = LDS_BYTES_ - 64;


DI float bf2f(unsigned short h) { return __uint_as_float((unsigned)h << 16); }
DI unsigned short f2bf(float f) { unsigned u = __float_as_uint(f); return (unsigned short)((u + 0x7fffu + ((u >> 16) & 1u)) >> 16); }
DI unsigned pk2(float lo, float hi) { return (unsigned)f2bf(lo) | ((unsigned)f2bf(hi) << 16); }
DI float lo_f(unsigned u) { return __uint_as_float(u << 16); }
DI float hi_f(unsigned u) { return __uint_as_float(u & 0xffff0000u); }
DI float sigmoidf_(float x) { return __builtin_amdgcn_rcpf(1.0f + __builtin_amdgcn_exp2f(x * -1.4426950408889634f)); }
DI unsigned cvtpk(float lo, float hi) { unsigned r; asm volatile("v_cvt_pk_bf16_f32 %0, %1, %2" : "=v"(r) : "v"(lo), "v"(hi)); return r; }
DI float ex2(float x) { return __builtin_amdgcn_exp2f(x); }
DI float wave_sum(float v) {
#pragma unroll
    for (int o = 1; o < 64; o <<= 1) v += __shfl_xor(v, o);
    return v;
}
#define MFMA16(a, b, c) __builtin_amdgcn_mfma_f32_16x16x32_bf16((a), (b), (c), 0, 0, 0)

namespace pg8 {
constexpr int BM = 256, BK = 64, HALF = 128, HTB = HALF * BK * 2, STAGE_BYTES = 8 * HTB, NXCD = 8, WGM = 2;
DI int lds_byte(int r, int c) { const int st = (r >> 4) * 2 + (c >> 5), rr = r & 15, cc = c & 31, ob = rr * 64 + cc * 2; return st * 1024 + (ob ^ (((ob >> 9) & 1) << 5)); }
DI void stage_rc(int b, int& R, int& C) { const int st = b / 1024, sb = b % 1024, swz = sb ^ (((sb >> 9) & 1) << 5); R = (st >> 1) * 16 + swz / 64; C = (st & 1) * 32 + (swz % 64) / 2; }
DI int perm32(int rho) { const int n = rho >> 4, i = rho & 15; return 8 * (i >> 2) + 4 * n + (i & 3); }
struct Unit { int pm, pn; };
struct Gemm { const bf16* A; const bf16* Bt; int M, N, K, lda; };
struct StaticOrder {
    int nM, nN, nwg, G, c;
    DI void init(int M, int N, int G_, int c_) { nM = M / BM; nN = N / BM; nwg = nM * nN; G = G_; c = c_; }
    DI bool next(int i, Unit& u) const {
        const long L = (long)i * G + c; if (L >= nwg) return false;
        int wgid = (int)L; { const int q = nwg / NXCD, r = nwg % NXCD, xcd = wgid % NXCD, off = wgid / NXCD; wgid = (xcd < r ? xcd * (q + 1) : r * (q + 1) + (xcd - r) * q) + off; }
        const int nig = WGM * nN, gid = wgid / nig, fm = gid * WGM, gsz = (nM - fm) < WGM ? (nM - fm) : WGM;
        u.pm = fm + ((wgid % nig) % gsz); u.pn = (wgid % nig) / gsz; return true;
    }
};
DI unsigned cvt_pk_bf16(float lo, float hi) { unsigned r; asm volatile("v_cvt_pk_bf16_f32 %0, %1, %2" : "=v"(r) : "v"(lo), "v"(hi)); return r; }

template <class Epi, bool ALIGN_EPI>
DI void gemm_phase(LAS unsigned char* lds, const Gemm g, const StaticOrder& S, const Epi& E, const int tid) {
    const int wid = __builtin_amdgcn_readfirstlane(tid >> 6), lane = tid & 63, wr = wid >> 2, wc = wid & 3, fr = lane & 15, fq = lane >> 4;
    const int K = g.K, nt = K / BK;
    unsigned voffA[2], voffB[2];
#pragma unroll
    for (int i = 0; i < 2; ++i) { int R, C; stage_rc(tid * 16 + i * 8192, R, C); const int Rb = Epi::PERM ? ((R & ~31) + perm32(R & 31)) : R;
        voffA[i] = (unsigned)(R * g.lda + C) * 2u; voffB[i] = (unsigned)(Rb * K + C) * 2u; }
    const size_t kstep = (size_t)(BK * 2);
    const size_t hstepA = (size_t)HALF * g.lda * 2, hstepB = (size_t)HALF * K * 2;
    const size_t tstepA = 2 * hstepA, tstepB = 2 * hstepB;
    const unsigned ldsw = (unsigned)wid * 1024u;
    const int aoff = lds_byte(wr * 64 + fr, fq * 8), boff = lds_byte(wc * 32 + fr, fq * 8);
#define PG8_SA(b, h) (((b) * 2 + (h)) * HTB)
#define PG8_SB(b, h) ((4 + (b) * 2 + (h)) * HTB)
#define PG8_STAGE(bufoff, gbase, voff) do { _Pragma("unroll") for (int _i = 0; _i < 2; ++_i) \
        __builtin_amdgcn_global_load_lds((const unsigned*)((const char*)(gbase) + (voff)[_i]), (LAS unsigned*)(lds + (bufoff) + ldsw + _i * 8192), 16, 0, 0); } while (0)
#define PG8_LDA(dst, b, h) do { _Pragma("unroll") for (int m = 0; m < 4; ++m) _Pragma("unroll") for (int k = 0; k < 2; ++k) dst[m][k] = *(const LAS bf16x8*)(lds + PG8_SA(b, h) + aoff + m * 2048 + k * 1024); } while (0)
#define PG8_LDB(dst, b, h) do { _Pragma("unroll") for (int n = 0; n < 2; ++n) _Pragma("unroll") for (int k = 0; k < 2; ++k) dst[n][k] = *(const LAS bf16x8*)(lds + PG8_SB(b, h) + boff + n * 2048 + k * 1024); } while (0)
#define PG8_MMA(ai, bj, At, Bt) do { __builtin_amdgcn_s_setprio(1); _Pragma("unroll") for (int m = 0; m < 4; ++m) _Pragma("unroll") for (int n = 0; n < 2; ++n) _Pragma("unroll") for (int k = 0; k < 2; ++k) \
        acc[ai][bj][m][n] = __builtin_amdgcn_mfma_f32_16x16x32_bf16(Bt[n][k], At[m][k], acc[ai][bj][m][n], 0, 0, 0); __builtin_amdgcn_s_setprio(0); } while (0)
#define PG8_WAIT_V(n) asm volatile("s_waitcnt vmcnt(" #n ")" ::: "memory")
#define PG8_WAIT_L(n) asm volatile("s_waitcnt lgkmcnt(" #n ")" ::: "memory")
#define PG8_BAR __builtin_amdgcn_s_barrier()
#define PG8_SCHED __builtin_amdgcn_sched_barrier(0)
    Unit cur, nxt; int ui = 0;
    if (!S.next(0, cur)) return;
    f32x4 acc[2][2][4][2];
#pragma unroll
    for (int a = 0; a < 2; ++a)
#pragma unroll
        for (int b = 0; b < 2; ++b)
#pragma unroll
            for (int m = 0; m < 4; ++m)
#pragma unroll
                for (int n = 0; n < 2; ++n) acc[a][b][m][n] = (f32x4){0.f, 0.f, 0.f, 0.f};
    bf16x8 At[4][2], B0[2][2], B1[2][2];
    const char* cA = (const char*)g.A + (size_t)cur.pm * tstepA; const char* cB = (const char*)g.Bt + (size_t)cur.pn * tstepB;
    PG8_STAGE(PG8_SB(0, 0), cB, voffB); PG8_STAGE(PG8_SB(0, 1), cB + hstepB, voffB); PG8_STAGE(PG8_SA(0, 0), cA, voffA); PG8_STAGE(PG8_SA(0, 1), cA + hstepA, voffA);
    if (wr == 1) PG8_BAR;
    PG8_WAIT_V(2); PG8_BAR;
    PG8_STAGE(PG8_SB(1, 0), cB + kstep, voffB); PG8_STAGE(PG8_SA(1, 0), cA + kstep, voffA); PG8_STAGE(PG8_SB(1, 1), cB + hstepB + kstep, voffB);
    PG8_WAIT_V(6); PG8_BAR;
    for (;;) {
        const bool has_next = S.next(ui + 1, nxt);
        const char* nA = has_next ? (const char*)g.A + (size_t)nxt.pm * tstepA : cA; const char* nB = has_next ? (const char*)g.Bt + (size_t)nxt.pn * tstepB : cB;
        for (int t = 0; t < nt; t += 2) {
            const bool last = (t == nt - 2);
            const char* a1 = cA + (size_t)(t + 1) * kstep;
            const char* a2 = last ? nA : cA + (size_t)(t + 2) * kstep; const char* b2 = last ? nB : cB + (size_t)(t + 2) * kstep;
            const char* a3 = a2 + kstep; const char* b3 = b2 + kstep;
            PG8_LDB(B0, 0, 0); PG8_LDB(B1, 0, 1); PG8_SCHED; PG8_LDA(At, 0, 0); PG8_STAGE(PG8_SA(1, 1), a1 + hstepA, voffA);
            PG8_WAIT_V(8); PG8_WAIT_L(0); PG8_BAR; PG8_MMA(0, 0, At, B0); PG8_MMA(0, 1, At, B1); PG8_BAR; PG8_SCHED;
            PG8_LDA(At, 0, 1); PG8_STAGE(PG8_SB(0, 0), b2, voffB); PG8_STAGE(PG8_SB(0, 1), b2 + hstepB, voffB); PG8_STAGE(PG8_SA(0, 0), a2, voffA);
            PG8_WAIT_V(8); PG8_WAIT_L(0); PG8_BAR; PG8_MMA(1, 0, At, B0); PG8_MMA(1, 1, At, B1); PG8_BAR; PG8_SCHED;
            PG8_LDB(B0, 1, 0); PG8_LDB(B1, 1, 1); PG8_SCHED; PG8_LDA(At, 1, 0); PG8_STAGE(PG8_SA(0, 1), a2 + hstepA, voffA);
            PG8_WAIT_V(8); PG8_WAIT_L(0); PG8_BAR; PG8_MMA(0, 0, At, B0); PG8_MMA(0, 1, At, B1); PG8_BAR; PG8_SCHED;
            PG8_LDA(At, 1, 1); PG8_STAGE(PG8_SB(1, 0), b3, voffB); PG8_STAGE(PG8_SB(1, 1), b3 + hstepB, voffB); PG8_STAGE(PG8_SA(1, 0), a3, voffA);
            PG8_WAIT_V(8); PG8_WAIT_L(0); PG8_BAR; PG8_MMA(1, 0, At, B0); PG8_MMA(1, 1, At, B1); PG8_BAR; PG8_SCHED;
        }
        if constexpr (ALIGN_EPI) { if (wr == 0) PG8_BAR; }
        E(acc, cur, wr, wc, fr, fq);
        if (!has_next) break;
#pragma unroll
        for (int a = 0; a < 2; ++a)
#pragma unroll
            for (int b = 0; b < 2; ++b)
#pragma unroll
                for (int m = 0; m < 4; ++m)
#pragma unroll
                    for (int n = 0; n < 2; ++n) acc[a][b][m][n] = (f32x4){0.f, 0.f, 0.f, 0.f};
        cur = nxt; cA = nA; cB = nB; ++ui;
        if constexpr (ALIGN_EPI) { if (wr == 1) PG8_BAR; }
    }
    PG8_WAIT_V(0);
    if constexpr (!ALIGN_EPI) { if (wr == 0) PG8_BAR; }
    PG8_BAR;
#undef PG8_SA
#undef PG8_SB
#undef PG8_STAGE
#undef PG8_LDA
#undef PG8_LDB
#undef PG8_MMA
#undef PG8_WAIT_V
#undef PG8_WAIT_L
#undef PG8_BAR
#undef PG8_SCHED
}

struct EpiIn {
    static constexpr bool PERM = true;
    bf16* P; const float* lb; const float* rope;
    DI void operator()(const f32x4 (&acc)[2][2][4][2], const Unit& u, int wr, int wc, int fr, int fq) const {
        const int seg = u.pn >> 1;
        int type, dir = 0;
        if (seg < 2) type = 0; else if (seg < 6) { type = 1; dir = (seg >= 4) ? 1 : 0; } else if (seg < 8) type = 2; else if (seg < 10) type = 0;
        else if (seg < 19) { const int t = (seg - 10) % 3; type = (t == 0) ? 4 : ((t == 1) ? 5 : 2); } else type = 3;
#pragma unroll
        for (int ai = 0; ai < 2; ++ai)
#pragma unroll
            for (int m = 0; m < 4; ++m) {
                const int row = u.pm * BM + ai * HALF + wr * 64 + m * 16 + fr;
                const int c0t = u.pn * BM;
                size_t toff; int pitch, lc;
                if (c0t < C_ATT) { toff = (size_t)(c0t >> 10) * PE1; pitch = 1024; lc = c0t & 1023; }
                else if (c0t < C_GH) { toff = OFF_ATT0 + (size_t)((c0t - C_ATT) >> 9) * PE2; pitch = 512; lc = (c0t - C_ATT) & 511; }
                else { toff = OFF_GH + (size_t)((c0t - C_GH) >> 10) * PE1; pitch = 1024; lc = (c0t - C_GH) & 1023; }
                bf16* rowp = P + toff + (size_t)row * pitch + lc;
#pragma unroll
                for (int bj = 0; bj < 2; ++bj) {
                    const int col0 = u.pn * BM + bj * HALF + wc * 32 + 8 * fq;
                    f32x4 v0 = acc[ai][bj][m][0], v1 = acc[ai][bj][m][1];
                    if (type == 0) {
#pragma unroll
                        for (int i = 0; i < 4; ++i) { v0[i] = v0[i] * sigmoidf_(v0[i]); v1[i] = v1[i] * sigmoidf_(v1[i]); }
                    } else if (type == 1) {
                        const float* lbp = lb + dir * 1024 + (col0 - (C_FF + 1024 * dir));
                        const f32x4 l0 = *(const f32x4*)lbp, l1 = *(const f32x4*)(lbp + 4);
#pragma unroll
                        for (int i = 0; i < 4; ++i) { v0[i] = __logf(l0[i] + (1.0f - l0[i]) * sigmoidf_(v0[i])); v1[i] = __logf(l1[i] + (1.0f - l1[i]) * sigmoidf_(v1[i])); }
                    } else if (type == 3) {
#pragma unroll
                        for (int i = 0; i < 4; ++i) { v0[i] = sigmoidf_(v0[i]); v1[i] = sigmoidf_(v1[i]); }
                    } else if (type == 4 || type == 5) {
                        if (wc == 0) {
                            const int pos = row & (SEQ - 1);
                            const float* rp = rope + ((size_t)pos * 16 + 8 * (fq & 1)) * 2;
                            const f32x4 ca = *(const f32x4*)rp, cb = *(const f32x4*)(rp + 4), cc = *(const f32x4*)(rp + 8), cd = *(const f32x4*)(rp + 12);
                            const float c[8] = {ca[0], ca[2], cb[0], cb[2], cc[0], cc[2], cd[0], cd[2]}, sn[8] = {ca[1], ca[3], cb[1], cb[3], cc[1], cc[3], cd[1], cd[3]};
                            const float sg = (fq < 2) ? -1.0f : 1.0f;
#pragma unroll
                            for (int i = 0; i < 4; ++i) {
                                const float p0 = __shfl_xor(v0[i], 32), p1 = __shfl_xor(v1[i], 32);
                                v0[i] = v0[i] * c[i] + sg * p0 * sn[i]; v1[i] = v1[i] * c[4 + i] + sg * p1 * sn[4 + i];
                            }
                        }
                        if (type == 4) { v0 = v0 * QSCALE_A; v1 = v1 * QSCALE_A; }
                    }
                    u32x4 w; w.x = cvt_pk_bf16(v0[0], v0[1]); w.y = cvt_pk_bf16(v0[2], v0[3]); w.z = cvt_pk_bf16(v1[0], v1[1]); w.w = cvt_pk_bf16(v1[2], v1[3]);
                    *(u32x4*)(rowp + bj * HALF + wc * 32 + 8 * fq) = w;
                }
            }
    }
};
struct EpiKV {
    static constexpr bool PERM = false;
    bf16* Km; bf16* Vt;
    DI void operator()(const f32x4 (&acc)[2][2][4][2], const Unit& u, int wr, int wc, int fr, int fq) const {
#pragma unroll
        for (int ai = 0; ai < 2; ++ai)
#pragma unroll
            for (int m = 0; m < 4; ++m) {
                const int row = u.pm * BM + ai * HALF + wr * 64 + m * 16 + fr;
#pragma unroll
                for (int bj = 0; bj < 2; ++bj)
#pragma unroll
                    for (int n = 0; n < 2; ++n) {
                        const int col0 = u.pn * BM + bj * HALF + wc * 32 + 16 * n + 4 * fq; const f32x4 v = acc[ai][bj][m][n];
                        if (col0 < 1024) { u32x2 w; w.x = cvt_pk_bf16(v[0], v[1]); w.y = cvt_pk_bf16(v[2], v[3]); *(u32x2*)(Km + (size_t)row * 1024 + col0) = w; }
                        else { const int cv = col0 - 1024, head = cv >> 8, d = cv & 255, sq = row >> 8, key = row & 255;
#pragma unroll
                            for (int i = 0; i < 4; ++i) Vt[((size_t)((sq * 4 + head) * 256 + d + i)) * 256 + key] = f2bf(v[i]); }
                    }
            }
    }
};
template <int WHICH> struct EpiY {
    static constexpr bool PERM = true;
    bf16* P;
    DI void operator()(const f32x4 (&acc)[2][2][4][2], const Unit& u, int wr, int wc, int fr, int fq) const {
#pragma unroll
        for (int ai = 0; ai < 2; ++ai)
#pragma unroll
            for (int m = 0; m < 4; ++m) {
                const int row = u.pm * BM + ai * HALF + wr * 64 + m * 16 + fr;
#pragma unroll
                for (int bj = 0; bj < 2; ++bj) {
                    const int col0 = u.pn * BM + bj * HALF + wc * 32 + 8 * fq;
                    bf16* gp = P + OFF_GH + (size_t)row * 1024 + col0;
                    const u32x4 gh = *(const u32x4*)gp;
                    const f32x4 a0 = acc[ai][bj][m][0], a1 = acc[ai][bj][m][1];
                    float o[8];
                    if (WHICH == 1) {
                        o[0] = lo_f(gh.x) * a0[0]; o[1] = hi_f(gh.x) * a0[1]; o[2] = lo_f(gh.y) * a0[2]; o[3] = hi_f(gh.y) * a0[3];
                        o[4] = lo_f(gh.z) * a1[0]; o[5] = hi_f(gh.z) * a1[1]; o[6] = lo_f(gh.w) * a1[2]; o[7] = hi_f(gh.w) * a1[3];
                    } else {
                        const u32x4 ga = *(const u32x4*)(gp + PE1);
                        o[0] = lo_f(gh.x) + lo_f(ga.x) * a0[0]; o[1] = hi_f(gh.x) + hi_f(ga.x) * a0[1]; o[2] = lo_f(gh.y) + lo_f(ga.y) * a0[2]; o[3] = hi_f(gh.y) + hi_f(ga.y) * a0[3];
                        o[4] = lo_f(gh.z) + lo_f(ga.z) * a1[0]; o[5] = hi_f(gh.z) + hi_f(ga.z) * a1[1]; o[6] = lo_f(gh.w) + lo_f(ga.w) * a1[2]; o[7] = hi_f(gh.w) + hi_f(ga.w) * a1[3];
                    }
                    u32x4 w; w.x = cvt_pk_bf16(o[0], o[1]); w.y = cvt_pk_bf16(o[2], o[3]); w.z = cvt_pk_bf16(o[4], o[5]); w.w = cvt_pk_bf16(o[6], o[7]);
                    *(u32x4*)gp = w;
                }
            }
    }
};
template <int MODE> struct EpiRes {
    static constexpr bool PERM = true;
    const float* xin; float* out; bf16* hb16; float* ss;
    DI void operator()(const f32x4 (&acc)[2][2][4][2], const Unit& u, int wr, int wc, int fr, int fq) const {
#pragma unroll
        for (int ai = 0; ai < 2; ++ai)
#pragma unroll
            for (int m = 0; m < 4; ++m) {
                const int row = u.pm * BM + ai * HALF + wr * 64 + m * 16 + fr;
                const size_t off = (size_t)row * DM + u.pn * BM + wc * 32 + 8 * fq;
                float part = 0.f;
#pragma unroll
                for (int bj = 0; bj < 2; ++bj) {
                    f32x4 v0, v1;
                    if (MODE == 0) { v0 = *(const f32x4*)(xin + off + bj * HALF); v1 = *(const f32x4*)(xin + off + bj * HALF + 4); }
                    else { const u32x4 hb = *(const u32x4*)(hb16 + off + bj * HALF); v0 = (f32x4){lo_f(hb.x), hi_f(hb.x), lo_f(hb.y), hi_f(hb.y)}; v1 = (f32x4){lo_f(hb.z), hi_f(hb.z), lo_f(hb.w), hi_f(hb.w)}; }
                    v0 = v0 + acc[ai][bj][m][0]; v1 = v1 + acc[ai][bj][m][1];
                    if (MODE == 2) { *(f32x4*)(out + off + bj * HALF) = v0; *(f32x4*)(out + off + bj * HALF + 4) = v1; }
                    else { u32x4 w; w.x = cvt_pk_bf16(v0[0], v0[1]); w.y = cvt_pk_bf16(v0[2], v0[3]); w.z = cvt_pk_bf16(v1[0], v1[1]); w.w = cvt_pk_bf16(v1[2], v1[3]); *(u32x4*)(hb16 + off + bj * HALF) = w;
                        v0 = (f32x4){lo_f(w.x), hi_f(w.x), lo_f(w.y), hi_f(w.y)}; v1 = (f32x4){lo_f(w.z), hi_f(w.z), lo_f(w.w), hi_f(w.w)}; }
                    part += (v0[0] * v0[0] + v0[1] * v0[1]) + (v0[2] * v0[2] + v0[3] * v0[3]) + (v1[0] * v1[0] + v1[1] * v1[1]) + (v1[2] * v1[2] + v1[3] * v1[3]);
                }
                part += __shfl_xor(part, 16); part += __shfl_xor(part, 32); if (fq == 0) ss[(size_t)row * 16 + u.pn * 4 + wc] = part;
            }
    }
};
template <int ACT> struct EpiBf {
    static constexpr bool PERM = true;
    bf16* O; int ldc; float scale; const float* ss;
    DI void operator()(const f32x4 (&acc)[2][2][4][2], const Unit& u, int wr, int wc, int fr, int fq) const {
#pragma unroll
        for (int ai = 0; ai < 2; ++ai)
#pragma unroll
            for (int m = 0; m < 4; ++m) {
                const int row = u.pm * BM + ai * HALF + wr * 64 + m * 16 + fr;
                bf16* rowp = O + (size_t)row * ldc + u.pn * BM + wc * 32 + 8 * fq;
                float ssum; { const f32x4* sp = (const f32x4*)(ss + (size_t)row * 16); const f32x4 s0 = sp[0], s1 = sp[1], s2 = sp[2], s3 = sp[3];
                    ssum = ((s0[0] + s0[1]) + (s0[2] + s0[3])) + ((s1[0] + s1[1]) + (s1[2] + s1[3])) + ((s2[0] + s2[1]) + (s2[2] + s2[3])) + ((s3[0] + s3[1]) + (s3[2] + s3[3])); }
                const float rstd = rsqrtf(ssum * (1.0f / DM) + RMS_EPS);
                const float sc = (ACT == 1) ? rstd * rstd : rstd * scale;
#pragma unroll
                for (int bj = 0; bj < 2; ++bj) {
                    f32x4 v0 = acc[ai][bj][m][0], v1 = acc[ai][bj][m][1];
                    if (ACT == 1) {
#pragma unroll
                        for (int i = 0; i < 4; ++i) { const float a = fmaxf(v0[i], 0.f), b = fmaxf(v1[i], 0.f); v0[i] = a * a * sc; v1[i] = b * b * sc; }
                    } else { v0 = v0 * sc; v1 = v1 * sc; }
                    u32x4 w; w.x = cvt_pk_bf16(v0[0], v0[1]); w.y = cvt_pk_bf16(v0[2], v0[3]); w.z = cvt_pk_bf16(v1[0], v1[1]); w.w = cvt_pk_bf16(v1[2], v1[3]);
                    *(u32x4*)(rowp + bj * HALF) = w;
                }
            }
    }
};
}

DI void p0_transpose_item(const float* W, int K, int N, bf16* WT, const float* gain, LAS float* scr, int item, int lane) {
    const int nblk = N / 32, kb = item / nblk, nb = item % nblk, k0 = 64 * kb, n0 = 32 * nb;
    float wv[32];
#pragma unroll
    for (int i = 0; i < 32; ++i) { const int kk = 2 * i + (lane >> 5); wv[i] = W[(size_t)(k0 + kk) * N + n0 + (lane & 31)]; }
    if (gain) {
#pragma unroll
        for (int i = 0; i < 32; ++i) wv[i] *= gain[k0 + 2 * i + (lane >> 5)];
    }
#pragma unroll
    for (int i = 0; i < 32; ++i) { const int kk = 2 * i + (lane >> 5); scr[kk * 33 + (lane & 31)] = wv[i]; }
    asm volatile("s_waitcnt lgkmcnt(0)" ::: "memory");
    const int c = lane & 7;
#pragma unroll
    for (int j = 0; j < 4; ++j) { const int n = (lane >> 3) + 8 * j; const LAS float* s = scr + (8 * c) * 33 + n;
        u32x4 o; o.x = pk2(s[0 * 33], s[1 * 33]); o.y = pk2(s[2 * 33], s[3 * 33]); o.z = pk2(s[4 * 33], s[5 * 33]); o.w = pk2(s[6 * 33], s[7 * 33]);
        *(u32x4*)(WT + (size_t)(n0 + n) * K + k0 + 8 * c) = o; }
    asm volatile("s_waitcnt lgkmcnt(0)" ::: "memory");
}
DI void norm_row_bf16(const float* xrow, bf16* orow, int lane) {
    const f32x4* xr = (const f32x4*)xrow + lane;
    f32x4 v[4]; float s = 0.f;
#pragma unroll
    for (int j = 0; j < 4; ++j) { v[j] = xr[64 * j]; s += (v[j].x * v[j].x + v[j].y * v[j].y) + (v[j].z * v[j].z + v[j].w * v[j].w); }
    const float rstd = rsqrtf(wave_sum(s) * (1.f / DM) + RMS_EPS);
    u32x2* o8 = (u32x2*)orow + lane;
#pragma unroll
    for (int j = 0; j < 4; ++j) { u32x2 w; w.x = pk2(v[j].x * rstd, v[j].y * rstd); w.y = pk2(v[j].z * rstd, v[j].w * rstd); o8[64 * j] = w; }
}
DI void final_row_ss(float* hrow, const float* g, const float* ssp, int lane) {
    f32x4* xr = (f32x4*)hrow + lane; const f32x4* gr = (const f32x4*)g + lane;
    const f32x4 s0 = ((const f32x4*)ssp)[0], s1 = ((const f32x4*)ssp)[1], s2 = ((const f32x4*)ssp)[2], s3 = ((const f32x4*)ssp)[3];
    const float ssrow = ((s0[0] + s0[1]) + (s0[2] + s0[3])) + ((s1[0] + s1[1]) + (s1[2] + s1[3])) + ((s2[0] + s2[1]) + (s2[2] + s2[3])) + ((s3[0] + s3[1]) + (s3[2] + s3[3]));
    const float rstd = rsqrtf(ssrow * (1.f / DM) + RMS_EPS);
    f32x4 v[4];
#pragma unroll
    for (int j = 0; j < 4; ++j) v[j] = xr[64 * j];
#pragma unroll
    for (int j = 0; j < 4; ++j) xr[64 * j] = v[j] * rstd * gr[64 * j];
}
DI void final_row(float* hrow, const float* g, int lane) {
    f32x4* xr = (f32x4*)hrow + lane; const f32x4* gr = (const f32x4*)g + lane;
    f32x4 v[4]; float s = 0.f;
#pragma unroll
    for (int j = 0; j < 4; ++j) { v[j] = xr[64 * j]; s += (v[j].x * v[j].x + v[j].y * v[j].y) + (v[j].z * v[j].z + v[j].w * v[j].w); }
    const float rstd = rsqrtf(wave_sum(s) * (1.f / DM) + RMS_EPS);
#pragma unroll
    for (int j = 0; j < 4; ++j) xr[64 * j] = v[j] * rstd * gr[64 * j];
}

constexpr int HG_QD = 0, HG_KD = 17408, HG_QS = 34816, HG_K0E = 52224, HG_KST = 60928, HG_VT = 79360, HG_AM = 97792, HG_TOT = 107008, HG_DL = 109056;
template <int PASS>
DI void hgrn_item(LAS unsigned char* lds, const bf16* Pb, bf16* Of, bf16* Ob, float* segL, float* segD, int item, int tid) {
    const int lane = tid & 63, w = __builtin_amdgcn_readfirstlane(tid >> 6), r16 = lane & 15, q4 = lane >> 4;
    const int sg = item & 7, dir = (item >> 3) & 1, head = (item >> 4) & 7, sq = item >> 7;
    if (PASS == 1 && sg == 7) return;
    const int kcol = tid & 127, qtr = tid >> 7;
    const char* ubq = (const char*)(Pb + OFF_Q + (size_t)sq * SEQ * 1024 + head * 128);
    const char* ubf = (const char*)(Pb + OFF_FF + (size_t)dir * PE1 + (size_t)sq * SEQ * 1024 + head * 128);
    const char* ubv = (const char*)(Pb + OFF_V + (size_t)sq * SEQ * 1024 + head * 128);
    const unsigned voff0 = (unsigned)kcol * 2u + (unsigned)(dir ? 63 - 16 * qtr : 16 * qtr) * 2048u;
    const int vstep = dir ? -2048 : 2048;
    bf16* Od = (dir ? Ob : Of) + (size_t)sq * SEQ * DM + head * 128 + 16 * w + r16;
    f32x4 S[8];
#pragma unroll
    for (int kt = 0; kt < 8; ++kt) S[kt] = (f32x4){0.f, 0.f, 0.f, 0.f};
    if (PASS == 2) {
        for (int s2 = 0; s2 < sg; ++s2) {
            const int it2 = item - sg + s2;
            const float* Lp = segL + (size_t)it2 * 16384 + (size_t)(w * 8) * 256 + lane;
            const float* Dp = segD + (size_t)it2 * 128 + 4 * q4;
#pragma unroll
            for (int kt = 0; kt < 8; ++kt) { const f32x4 d = *(const f32x4*)(Dp + 16 * kt);
#pragma unroll
                for (int i = 0; i < 4; ++i) S[kt][i] = d[i] * S[kt][i] + Lp[(kt * 4 + i) * 64]; }
        }
    }
    float bseg = 0.f;
    LAS float* TOT = (LAS float*)(lds + HG_TOT); LAS float* DL = (LAS float*)(lds + HG_DL);
    unsigned short qv[16], vv[16], lfn[16];
#define HG_LOAD(pp) do { const size_t cb_ = (size_t)(dir ? (SEQ - 64 * ((pp) + 1)) : (64 * (pp))) * 2048;     \
        const char* cq_ = ubq + cb_; const char* cf_ = ubf + cb_; const char* cv_ = ubv + cb_; \
        _Pragma("unroll") for (int i = 0; i < 16; ++i) { const unsigned vo_ = voff0 + (unsigned)(vstep * i); \
            lfn[i] = *(const bf16*)(cf_ + vo_); vv[i] = *(const bf16*)(cv_ + vo_); if (PASS == 2) qv[i] = *(const bf16*)(cq_ + vo_); } } while (0)
    HG_LOAD(sg * 16);
    for (int j = 0; j < 16; ++j) {
        const int p = sg * 16 + j;
        float cs[16]; unsigned short lfr[16];
#pragma unroll
        for (int i = 0; i < 16; ++i) lfr[i] = lfn[i];
        { float run = 0.f;
#pragma unroll
          for (int i = 0; i < 16; ++i) { run += bf2f(lfr[i]); cs[i] = run; } }
        TOT[qtr * 128 + kcol] = cs[15];
        { u32x4 a, b; a.x = vv[0] | ((unsigned)vv[1] << 16); a.y = vv[2] | ((unsigned)vv[3] << 16); a.z = vv[4] | ((unsigned)vv[5] << 16); a.w = vv[6] | ((unsigned)vv[7] << 16);
          b.x = vv[8] | ((unsigned)vv[9] << 16); b.y = vv[10] | ((unsigned)vv[11] << 16); b.z = vv[12] | ((unsigned)vv[13] << 16); b.w = vv[14] | ((unsigned)vv[15] << 16);
          LAS u32x4* vp = (LAS u32x4*)(lds + HG_VT + kcol * 144 + qtr * 32); vp[0] = a; vp[1] = b; }
        __syncthreads();
        const float t0 = TOT[kcol], t1 = TOT[128 + kcol], t2 = TOT[256 + kcol], t3 = TOT[384 + kcol];
        const float off = (qtr > 0 ? t0 : 0.f) + (qtr > 1 ? t1 : 0.f) + (qtr > 2 ? t2 : 0.f);
        const float r1 = t0 + t1, blast = (t0 + t1) + (t2 + t3);
        const float rblk = (qtr >= 2) ? r1 : 0.f;
        if (qtr == 0) { DL[kcol] = ex2(blast * 1.4426950408889634f); bseg += blast; }
        unsigned ks[8];
        constexpr float L2E = 1.4426950408889634f;
        const float er1 = ex2(r1 * L2E), ebl1 = ex2((blast - r1) * L2E);
#pragma unroll
        for (int i = 0; i < 16; i += 2) {
            float kk[2], bb[2], e1[2], e2[2], eks[2], e3[2];
#pragma unroll
            for (int e = 0; e < 2; ++e) {
                bb[e] = off + cs[i + e]; kk[e] = 1.0f - ex2(bf2f(lfr[i + e]) * L2E);
                if (qtr < 2) {
                    e1[e] = ex2(bb[e] * L2E); e2[e] = ex2(fminf(-bb[e], 80.f) * L2E); e3[e] = ex2((r1 - bb[e]) * L2E); eks[e] = e3[e] * ebl1;
                } else {
                    e1[e] = ex2((bb[e] - r1) * L2E); e2[e] = ex2(fminf(r1 - bb[e], 80.f) * L2E); e3[e] = 0.f; eks[e] = ex2((blast - bb[e]) * L2E);
                }
            }
            ks[i >> 1] = cvtpk(kk[0] * eks[0], kk[1] * eks[1]);
            if (PASS == 2) {
                const float q0 = bf2f(qv[i]), q1 = bf2f(qv[i + 1]);
                const int tau = 16 * qtr + i;
                const unsigned wqd = cvtpk(q0 * e1[0], q1 * e1[1]);
                const unsigned wkd = cvtpk(kk[0] * e2[0], kk[1] * e2[1]);
                const unsigned wqs = (qtr < 2) ? wqd : cvtpk(q0 * e1[0] * er1, q1 * e1[1] * er1);
                *(LAS bf16*)(lds + HG_QD + tau * 272 + kcol * 2) = (bf16)(wqd & 0xffffu); *(LAS bf16*)(lds + HG_QD + (tau + 1) * 272 + kcol * 2) = (bf16)(wqd >> 16);
                *(LAS bf16*)(lds + HG_KD + tau * 272 + kcol * 2) = (bf16)(wkd & 0xffffu); *(LAS bf16*)(lds + HG_KD + (tau + 1) * 272 + kcol * 2) = (bf16)(wkd >> 16);
                *(LAS bf16*)(lds + HG_QS + tau * 272 + kcol * 2) = (bf16)(wqs & 0xffffu); *(LAS bf16*)(lds + HG_QS + (tau + 1) * 272 + kcol * 2) = (bf16)(wqs >> 16);
                if (qtr < 2) { const unsigned wk0 = cvtpk(kk[0] * e3[0], kk[1] * e3[1]);
                    *(LAS bf16*)(lds + HG_K0E + tau * 272 + kcol * 2) = (bf16)(wk0 & 0xffffu); *(LAS bf16*)(lds + HG_K0E + (tau + 1) * 272 + kcol * 2) = (bf16)(wk0 >> 16); }
            }
        }
        { LAS u32x4* kp = (LAS u32x4*)(lds + HG_KST + kcol * 144 + qtr * 32); kp[0] = (u32x4){ks[0], ks[1], ks[2], ks[3]}; kp[1] = (u32x4){ks[4], ks[5], ks[6], ks[7]}; }
        __syncthreads();
        if (j + 1 < 16) HG_LOAD(p + 1);
        if (PASS == 2) {
            const int ti = w >> 1;
#pragma unroll
            for (int e = 0; e < 2; ++e) {
                const int sj = 2 * (w & 1) + e;
                f32x4 a4 = (f32x4){0.f, 0.f, 0.f, 0.f};
                if (sj <= ti) {
                    const int bsrc = (ti >= 2 && sj < 2) ? HG_K0E : HG_KD;
                    bf16x8 fa[4], fb[4];
#pragma unroll
                    for (int st = 0; st < 4; ++st) {
                        fa[st] = *(const LAS bf16x8*)(lds + HG_QD + (16 * ti + r16) * 272 + (32 * st + 8 * q4) * 2);
                        fb[st] = *(const LAS bf16x8*)(lds + bsrc + (16 * sj + r16) * 272 + (32 * st + 8 * q4) * 2);
                    }
                    __builtin_amdgcn_sched_barrier(0);
#pragma unroll
                    for (int st = 0; st < 4; ++st) a4 = MFMA16(fa[st], fb[st], a4);
                    __builtin_amdgcn_sched_barrier(0);
                }
#pragma unroll
                for (int i = 0; i < 4; ++i) { const int t = 16 * ti + 4 * q4 + i, s = 16 * sj + r16; *(LAS bf16*)(lds + HG_AM + t * 144 + s * 2) = f2bf(s <= t ? a4[i] : 0.f); }
            }
            __syncthreads();
        }
        bf16x8 bv[2];
#pragma unroll
        for (int st = 0; st < 2; ++st) bv[st] = *(const LAS bf16x8*)(lds + HG_VT + (16 * w + r16) * 144 + (32 * st + 8 * q4) * 2);
        if (PASS == 2) {
            bf16x8 sb[4];
#pragma unroll
            for (int k2 = 0; k2 < 4; ++k2) { u32x4 pz; pz.x = pk2(S[2 * k2][0], S[2 * k2][1]); pz.y = pk2(S[2 * k2][2], S[2 * k2][3]); pz.z = pk2(S[2 * k2 + 1][0], S[2 * k2 + 1][1]); pz.w = pk2(S[2 * k2 + 1][2], S[2 * k2 + 1][3]);
                sb[k2] = __builtin_bit_cast(bf16x8, pz); }
#pragma unroll
            for (int ti = 0; ti < 4; ++ti) {
                f32x4 o4 = (f32x4){0.f, 0.f, 0.f, 0.f};
                bf16x8 fam[2]; s16x4 ql[4], qh[4];
#pragma unroll
                for (int st = 0; st < 2; ++st) fam[st] = *(const LAS bf16x8*)(lds + HG_AM + (16 * ti + r16) * 144 + (32 * st + 8 * q4) * 2);
#pragma unroll
                for (int k2 = 0; k2 < 4; ++k2) {
                    ql[k2] = *(const LAS s16x4*)(lds + HG_QS + (16 * ti + r16) * 272 + (32 * k2 + 4 * q4) * 2);
                    qh[k2] = *(const LAS s16x4*)(lds + HG_QS + (16 * ti + r16) * 272 + (32 * k2 + 16 + 4 * q4) * 2);
                }
                __builtin_amdgcn_sched_barrier(0);
#pragma unroll
                for (int st = 0; st < 2; ++st) o4 = MFMA16(fam[st], bv[st], o4);
#pragma unroll
                for (int k2 = 0; k2 < 4; ++k2) o4 = MFMA16(__builtin_shufflevector(ql[k2], qh[k2], 0, 1, 2, 3, 4, 5, 6, 7), sb[k2], o4);
                __builtin_amdgcn_sched_barrier(0);
#pragma unroll
                for (int i = 0; i < 4; ++i) { const int tau = 16 * ti + 4 * q4 + i; const int tok = dir ? (SEQ - 1 - 64 * p - tau) : (64 * p + tau); Od[(size_t)tok * DM] = f2bf(o4[i]); }
            }
        }
#pragma unroll
        for (int kh = 0; kh < 2; ++kh) {
            bf16x8 fk[4][2]; f32x4 dd[4];
#pragma unroll
            for (int k4 = 0; k4 < 4; ++k4) { const int kt = 4 * kh + k4;
                dd[k4] = *(const LAS f32x4*)(lds + HG_DL + (16 * kt + 4 * q4) * 4);
#pragma unroll
                for (int st = 0; st < 2; ++st) fk[k4][st] = *(const LAS bf16x8*)(lds + HG_KST + (16 * kt + r16) * 144 + (32 * st + 8 * q4) * 2); }
            __builtin_amdgcn_sched_barrier(0);
#pragma unroll
            for (int k4 = 0; k4 < 4; ++k4) { const int kt = 4 * kh + k4; S[kt] = S[kt] * dd[k4]; }
#pragma unroll
            for (int st = 0; st < 2; ++st)
#pragma unroll
                for (int k4 = 0; k4 < 4; ++k4) { const int kt = 4 * kh + k4; S[kt] = MFMA16(fk[k4][st], bv[st], S[kt]); }
            __builtin_amdgcn_sched_barrier(0);
        }
        __syncthreads();
    }
    if (PASS == 1) {
        float* Lp = segL + (size_t)item * 16384 + (size_t)(w * 8) * 256 + lane;
#pragma unroll
        for (int kt = 0; kt < 8; ++kt)
#pragma unroll
            for (int i = 0; i < 4; ++i) Lp[(kt * 4 + i) * 64] = S[kt][i];
        if (qtr == 0) segD[(size_t)item * 128 + kcol] = __expf(bseg);
    }
}

constexpr int DA_K = 0, DA_V = 69632;
typedef short v4i16_t __attribute__((ext_vector_type(4)));
DI s16x4 vtr(LAS unsigned char* p) { return __builtin_bit_cast(s16x4, __builtin_amdgcn_ds_read_tr16_b64_v4i16((LAS v4i16_t*)p)); }
struct DaIdx { int head, g, sq, dil, L, res, m0, qcol; };
DI DaIdx da_index(int item) {
    DaIdx d; const int idx = item & 63; d.head = (item >> 6) & 3; d.g = (item >> 8) % 3; d.sq = (item >> 8) / 3;
    d.dil = (d.g == 0) ? 1 : ((d.g == 1) ? 4 : 16); d.L = SEQ / d.dil; const int tpr = d.L / 128; d.res = idx / tpr; d.m0 = 128 * (idx % tpr);
    d.qcol = 128 * d.head; return d;
}
DI void da_load(const bf16* Pb, int item, int tid, u32x4 (&kreg)[8], u32x4 (&vreg)[8], bf16x8 (&qf)[4]) {
    const DaIdx d = da_index(item);
    const int lane = tid & 63, w = tid >> 6, r16 = lane & 15, q4 = lane >> 4;
    const bf16* rowbase = Pb + OFF_ATT0 + (size_t)(3 * d.g) * PE2 + (size_t)d.sq * SEQ * 512;
    const bf16* qrow = rowbase + (size_t)((d.m0 + 16 * w + r16) * d.dil + d.res) * 512 + d.qcol;
#pragma unroll
    for (int st = 0; st < 4; ++st) qf[st] = *(const bf16x8*)(qrow + 32 * st + 8 * q4);
#pragma unroll
    for (int it = 0; it < 8; ++it) {
        const int e = it * 512 + tid, key = e >> 4, ch = e & 15, m = d.m0 - 64 + key;
        kreg[it] = (u32x4){0u, 0u, 0u, 0u}; vreg[it] = kreg[it];
        if (m >= 0 && m < d.L) { const bf16* rp = rowbase + (size_t)(m * d.dil + d.res) * 512 + d.qcol + ch * 8; kreg[it] = *(const u32x4*)(rp + PE2); vreg[it] = *(const u32x4*)(rp + 2 * PE2); }
    }
}
DI void dattn_items(LAS unsigned char* lds, bf16* Pb, float* lse, int first, int stride, int nitems, int tid) {
    const int lane = tid & 63, w = __builtin_amdgcn_readfirstlane(tid >> 6), r16 = lane & 15, q4 = lane >> 4;
    u32x4 kreg[8], vreg[8]; bf16x8 qn[4];
    if (first < nitems) da_load(Pb, first, tid, kreg, vreg, qn);
    for (int item = first; item < nitems; item += stride) {
    const DaIdx d = da_index(item);
    const int head = d.head, g = d.g, sq = d.sq, dil = d.dil, L = d.L, res = d.res, m0 = d.m0, qcol = d.qcol;
    bf16* rowbase = Pb + OFF_ATT0 + (size_t)(3 * g) * PE2 + (size_t)sq * SEQ * 512;
    const int mq = m0 + 16 * w + r16;
    bf16* qrow = rowbase + (size_t)(mq * dil + res) * 512 + qcol;
    bf16x8 qf[4];
#pragma unroll
    for (int st = 0; st < 4; ++st) qf[st] = qn[st];
#pragma unroll
    for (int it = 0; it < 8; ++it) {
        const int e = it * 512 + tid, key = e >> 4, ch = e & 15;
        *(LAS u32x4*)(lds + DA_K + key * 272 + ch * 16) = kreg[it];
        *(LAS u32x4*)(lds + DA_V + key * 288 + ch * 16) = vreg[it];
    }
    __syncthreads();
    if (item + stride < nitems) da_load(Pb, item + stride, tid, kreg, vreg, qn);
    f32x4 sc[9];
    float mx = -1e30f;
#pragma unroll
    for (int kt = 0; kt < 9; ++kt) {
        f32x4 a4 = (f32x4){0.f, 0.f, 0.f, 0.f};
        bf16x8 fa[4];
#pragma unroll
        for (int st = 0; st < 4; ++st) fa[st] = *(const LAS bf16x8*)(lds + DA_K + (16 * w + 16 * kt + r16) * 272 + (32 * st + 8 * q4) * 2);
        __builtin_amdgcn_sched_barrier(0);
#pragma unroll
        for (int st = 0; st < 4; ++st) a4 = MFMA16(fa[st], qf[st], a4);
        __builtin_amdgcn_sched_barrier(0);
#pragma unroll
        for (int i = 0; i < 4; ++i) { const int mk = m0 - 64 + 16 * w + 16 * kt + 4 * q4 + i; const int dd = mk - mq;
            const bool ok = (mk >= 0) && (mk < L) && (dd <= 64) && (dd >= -64); a4[i] = ok ? a4[i] : -1e30f; mx = fmaxf(mx, a4[i]); }
        sc[kt] = a4;
    }
    mx = fmaxf(mx, __shfl_xor(mx, 16)); mx = fmaxf(mx, __shfl_xor(mx, 32));
    float sum = 0.f;
#pragma unroll
    for (int kt = 0; kt < 9; ++kt)
#pragma unroll
        for (int i = 0; i < 4; ++i) { const float pv = __builtin_amdgcn_exp2f(sc[kt][i] - mx); sc[kt][i] = pv; sum += pv; }
    sum += __shfl_xor(sum, 16); sum += __shfl_xor(sum, 32);
    bf16x8 pb[5];
#pragma unroll
    for (int pp = 0; pp < 5; ++pp) { u32x4 pz; pz.x = pk2(sc[2 * pp][0], sc[2 * pp][1]); pz.y = pk2(sc[2 * pp][2], sc[2 * pp][3]);
        if (pp < 4) { pz.z = pk2(sc[2 * pp + 1][0], sc[2 * pp + 1][1]); pz.w = pk2(sc[2 * pp + 1][2], sc[2 * pp + 1][3]); } else { pz.z = 0u; pz.w = 0u; }
        pb[pp] = __builtin_bit_cast(bf16x8, pz); }
    const float rs = 1.0f / sum;
#pragma unroll
    for (int dt = 0; dt < 8; ++dt) {
        f32x4 o4 = (f32x4){0.f, 0.f, 0.f, 0.f};
        s16x4 vl[5], vh[5];
#pragma unroll
        for (int pp = 0; pp < 5; ++pp) {
            LAS unsigned char* vb = lds + DA_V + (16 * w + 32 * pp + 4 * q4 + (r16 >> 2)) * 288 + (16 * dt + 4 * (r16 & 3)) * 2;
            vl[pp] = vtr(vb);
            vh[pp] = vtr(pp < 4 ? vb + 16 * 288 : vb);
        }
        __builtin_amdgcn_sched_barrier(0);
#pragma unroll
        for (int pp = 0; pp < 5; ++pp) o4 = MFMA16(__builtin_shufflevector(vl[pp], vh[pp], 0, 1, 2, 3, 4, 5, 6, 7), pb[pp], o4);
        __builtin_amdgcn_sched_barrier(0);
        u32x2 wv; wv.x = pk2(o4[0] * rs, o4[1] * rs); wv.y = pk2(o4[2] * rs, o4[3] * rs);
        *(u32x2*)(qrow + 16 * dt + 4 * q4) = wv;
    }
    if (q4 == 0) lse[((size_t)sq * SEQ + (size_t)(mq * dil + res)) * 12 + g * 4 + head] = mx + __builtin_amdgcn_logf(sum);
    __syncthreads();
    }
}

DI void xattn_item(LAS unsigned char* lds, bf16* Qx, const bf16* Kmem, const bf16* Vtmem, int b, int item, int tid) {
    const int lane = tid & 63, w = __builtin_amdgcn_readfirstlane(tid >> 6), r16 = lane & 15, q4 = lane >> 4;
    const int qt = item & 63, head = (item >> 6) & 3, sq = item >> 8, mseq = 2 * b + sq;
    const bf16* Kg = Kmem + (size_t)mseq * 256 * 1024 + head * 256;
    const bf16* Vg = Vtmem + (size_t)(mseq * 4 + head) * 256 * 256;
    bf16* qrow = Qx + ((size_t)sq * SEQ + 128 * qt + 16 * w + r16) * DM + head * 256;
    bf16x8 qf[8];
#pragma unroll
    for (int st = 0; st < 8; ++st) qf[st] = *(const bf16x8*)(qrow + 32 * st + 8 * q4);
    {
        u32x4 kreg[16];
#pragma unroll
        for (int it = 0; it < 16; ++it) { const int e = it * 512 + tid, key = e >> 5, ch = e & 31; kreg[it] = *(const u32x4*)(Kg + (size_t)key * 1024 + ch * 8); }
#pragma unroll
        for (int it = 0; it < 16; ++it) { const int e = it * 512 + tid, key = e >> 5, ch = e & 31; *(LAS u32x4*)(lds + key * 528 + ch * 16) = kreg[it]; }
    }
    __syncthreads();
    f32x4 sc[16]; float mx = -1e30f;
#define XA_KREAD(dst, kt_) _Pragma("unroll") for (int st = 0; st < 8; ++st) dst[st] = *(const LAS bf16x8*)(lds + (16 * (kt_) + r16) * 528 + (32 * st + 8 * q4) * 2)
#define XA_TILE(src, kt_) do { f32x4 a4 = (f32x4){0.f, 0.f, 0.f, 0.f}; _Pragma("unroll") for (int st = 0; st < 8; ++st) a4 = MFMA16(src[st], qf[st], a4); \
        _Pragma("unroll") for (int i = 0; i < 4; ++i) mx = fmaxf(mx, a4[i]); sc[kt_] = a4; } while (0)
    {
#pragma unroll
        for (int kt = 0; kt < 16; ++kt) {
            bf16x8 fa[8];
            XA_KREAD(fa, kt); __builtin_amdgcn_sched_barrier(0);
            XA_TILE(fa, kt); __builtin_amdgcn_sched_barrier(0);
        }
    }
    mx = fmaxf(mx, __shfl_xor(mx, 16)); mx = fmaxf(mx, __shfl_xor(mx, 32));
    float sum = 0.f;
#pragma unroll
    for (int kt = 0; kt < 16; ++kt)
#pragma unroll
        for (int i = 0; i < 4; ++i) { const float pv = __builtin_amdgcn_exp2f(sc[kt][i] - mx); sc[kt][i] = pv; sum += pv; }
    sum += __shfl_xor(sum, 16); sum += __shfl_xor(sum, 32);
    bf16x8 pb[8];
#pragma unroll
    for (int pp = 0; pp < 8; ++pp) { u32x4 pz; pz.x = pk2(sc[2 * pp][0], sc[2 * pp][1]); pz.y = pk2(sc[2 * pp][2], sc[2 * pp][3]); pz.z = pk2(sc[2 * pp + 1][0], sc[2 * pp + 1][1]); pz.w = pk2(sc[2 * pp + 1][2], sc[2 * pp + 1][3]);
        pb[pp] = __builtin_bit_cast(bf16x8, pz); }
    {
        u32x4 vreg[16];
#pragma unroll
        for (int it = 0; it < 16; ++it) { const int e = it * 512 + tid, d = e >> 5, ch = e & 31; vreg[it] = *(const u32x4*)(Vg + (size_t)d * 256 + ch * 8); }
        __syncthreads();
#pragma unroll
        for (int it = 0; it < 16; ++it) { const int e = it * 512 + tid, d = e >> 5, ch = e & 31; *(LAS u32x4*)(lds + d * 528 + ch * 16) = vreg[it]; }
    }
    __syncthreads();
    const float rs = __builtin_amdgcn_rcpf(sum);
#define XA_VREAD(dst, dt_) _Pragma("unroll") for (int pp = 0; pp < 8; ++pp) { dst[2 * pp] = *(const LAS s16x4*)(lds + (16 * (dt_) + r16) * 528 + (32 * pp + 4 * q4) * 2); \
        dst[2 * pp + 1] = *(const LAS s16x4*)(lds + (16 * (dt_) + r16) * 528 + (32 * pp + 16 + 4 * q4) * 2); }
#define XA_OTILE(src, dt_) do { f32x4 o4 = (f32x4){0.f, 0.f, 0.f, 0.f}; _Pragma("unroll") for (int pp = 0; pp < 8; ++pp) o4 = MFMA16(__builtin_shufflevector(src[2 * pp], src[2 * pp + 1], 0, 1, 2, 3, 4, 5, 6, 7), pb[pp], o4); \
        u32x2 wv; wv.x = cvtpk(o4[0] * rs, o4[1] * rs); wv.y = cvtpk(o4[2] * rs, o4[3] * rs); *(u32x2*)(qrow + 16 * (dt_) + 4 * q4) = wv; } while (0)
    {
#pragma unroll
        for (int dt = 0; dt < 16; ++dt) {
            s16x4 va[16];
            XA_VREAD(va, dt); __builtin_amdgcn_sched_barrier(0);
            XA_OTILE(va, dt); __builtin_amdgcn_sched_barrier(0);
        }
    }
    __syncthreads();
}

DI void post_row(bf16* P, int m, const bf16* ofr, const bf16* obr, const float* lser, const float* gn, bf16* Urow, int lane) {
    bf16* arow = P + OFF_ATT0 + (size_t)m * 512 + 8 * lane; const bf16* grow = P + OFF_G + (size_t)m * 1024;
    { const int h = lane >> 4; const float l0 = lser[h], l1 = lser[4 + h], l2 = lser[8 + h]; const float mxl = fmaxf(l0, fmaxf(l1, l2));
      float w0 = __builtin_amdgcn_exp2f(l0 - mxl), w1 = __builtin_amdgcn_exp2f(l1 - mxl), w2 = __builtin_amdgcn_exp2f(l2 - mxl); const float rs = 1.0f / (w0 + w1 + w2); w0 *= rs; w1 *= rs; w2 *= rs;
      const u32x4 a = *(const u32x4*)arow, b = *(const u32x4*)(arow + 3 * PE2), c = *(const u32x4*)(arow + 6 * PE2);
      u32x4 o;
      o.x = pk2(w0 * lo_f(a.x) + w1 * lo_f(b.x) + w2 * lo_f(c.x), w0 * hi_f(a.x) + w1 * hi_f(b.x) + w2 * hi_f(c.x));
      o.y = pk2(w0 * lo_f(a.y) + w1 * lo_f(b.y) + w2 * lo_f(c.y), w0 * hi_f(a.y) + w1 * hi_f(b.y) + w2 * hi_f(c.y));
      o.z = pk2(w0 * lo_f(a.z) + w1 * lo_f(b.z) + w2 * lo_f(c.z), w0 * hi_f(a.z) + w1 * hi_f(b.z) + w2 * hi_f(c.z));
      o.w = pk2(w0 * lo_f(a.w) + w1 * lo_f(b.w) + w2 * lo_f(c.w), w0 * hi_f(a.w) + w1 * hi_f(b.w) + w2 * hi_f(c.w));
      *(u32x4*)arow = o; }
    { float o[16];
#pragma unroll
      for (int hlf = 0; hlf < 2; ++hlf) { const u32x4 a = *(const u32x4*)(ofr + 16 * lane + 8 * hlf), b = *(const u32x4*)(obr + 16 * lane + 8 * hlf);
          o[8 * hlf + 0] = lo_f(a.x) + lo_f(b.x); o[8 * hlf + 1] = hi_f(a.x) + hi_f(b.x); o[8 * hlf + 2] = lo_f(a.y) + lo_f(b.y); o[8 * hlf + 3] = hi_f(a.y) + hi_f(b.y);
          o[8 * hlf + 4] = lo_f(a.z) + lo_f(b.z); o[8 * hlf + 5] = hi_f(a.z) + hi_f(b.z); o[8 * hlf + 6] = lo_f(a.w) + lo_f(b.w); o[8 * hlf + 7] = hi_f(a.w) + hi_f(b.w); }
      float ss = 0.f;
#pragma unroll
      for (int i = 0; i < 16; ++i) ss += o[i] * o[i];
      ss += __shfl_xor(ss, 1); ss += __shfl_xor(ss, 2); ss += __shfl_xor(ss, 4);
      const float rstd = rsqrtf(ss * (1.0f / 128.0f) + RMS_EPS);
      const int vc = (16 * lane) & 127;
#pragma unroll
      for (int hlf = 0; hlf < 2; ++hlf) { const u32x4 gsl = *(const u32x4*)(grow + 16 * lane + 8 * hlf);
          const f32x4 g0 = *(const f32x4*)(gn + vc + 8 * hlf), g1 = *(const f32x4*)(gn + vc + 8 * hlf + 4);
          u32x4 wv;
          wv.x = pk2(o[8 * hlf + 0] * rstd * g0[0] * lo_f(gsl.x), o[8 * hlf + 1] * rstd * g0[1] * hi_f(gsl.x));
          wv.y = pk2(o[8 * hlf + 2] * rstd * g0[2] * lo_f(gsl.y), o[8 * hlf + 3] * rstd * g0[3] * hi_f(gsl.y));
          wv.z = pk2(o[8 * hlf + 4] * rstd * g1[0] * lo_f(gsl.z), o[8 * hlf + 5] * rstd * g1[1] * hi_f(gsl.z));
          wv.w = pk2(o[8 * hlf + 6] * rstd * g1[2] * lo_f(gsl.w), o[8 * hlf + 7] * rstd * g1[3] * hi_f(gsl.w));
          *(u32x4*)(Urow + 16 * lane + 8 * hlf) = wv; } }
}

#define XB_TMO      128
#define XB_XCNT(j)  (256  + 64 * (j))
#define XB_XSUB(j)  (1280 + 64 * (j))
#define XB_XGEN(j)  (2304 + 64 * (j))
#define XB_TOP      3328
#define XB_TOPGEN   3392
#define XCD_BAR_WORDS 3456
#define XB_SPIN_CAP (1u << 18)
DI unsigned xb_ld(unsigned* p)              { return __hip_atomic_load(p, __ATOMIC_RELAXED, __HIP_MEMORY_SCOPE_AGENT); }
DI unsigned xb_add(unsigned* p, unsigned v) { return __hip_atomic_fetch_add(p, v, __ATOMIC_RELAXED, __HIP_MEMORY_SCOPE_AGENT); }
DI unsigned xb_xcc_id() { return (unsigned)__builtin_amdgcn_s_getreg((3 << 11) | 20) & 0xFu; }
#define XB_SPIN(cond, bar) do { unsigned _sp = 0; while (cond) { __builtin_amdgcn_s_sleep(1); \
    if ((++_sp & 255u) == 0u) { if (xb_ld(&(bar)[XB_TMO])) break; if (_sp > XB_SPIN_CAP) { atomicAdd(&(bar)[XB_TMO], 1u); break; } } } } while (0)
struct XcdBarrier { unsigned* bar; unsigned x; volatile LAS unsigned* st; };
DI XcdBarrier xcd_barrier_post(unsigned* bar, volatile LAS unsigned* st) {
    XcdBarrier b; b.bar = bar; b.x = xb_xcc_id(); b.st = st;
    if (threadIdx.x == 0) (void)xb_add(&bar[XB_XCNT(b.x)], 1u);
    return b;
}
DI void xcd_barrier_complete(unsigned* bar, unsigned x, unsigned& nloc, unsigned& nx) {
    const unsigned G = gridDim.x * gridDim.y * gridDim.z;
    unsigned sum, cnt, mine, sp = 0u;
    for (;;) {
        sum = 0u; cnt = 0u; mine = 0u;
#pragma unroll
        for (unsigned j = 0; j < 16; ++j) { const unsigned c = xb_ld(&bar[XB_XCNT(j)]); sum += c; cnt += (c > 0u) ? 1u : 0u; mine = (j == x) ? c : mine; }
        if (sum == G) break;
        __builtin_amdgcn_s_sleep(1);
        if ((++sp & 255u) == 0u) { if (xb_ld(&bar[XB_TMO])) break; if (sp > XB_SPIN_CAP) { atomicAdd(&bar[XB_TMO], 1u); break; } }
    }
    nloc = mine > 0u ? mine : 1u; nx = cnt > 0u ? cnt : 1u;
}
DI void xcd_barrier(const XcdBarrier& b) {
    asm volatile("s_waitcnt vmcnt(0)" ::: "memory");
    __syncthreads();
    if (threadIdx.x == 0) {
        unsigned* bar = b.bar;
        __builtin_amdgcn_s_waitcnt(0);
        unsigned nloc = b.st[0], nx = b.st[1];
        if (nloc == 0u) { xcd_barrier_complete(bar, b.x, nloc, nx); b.st[0] = nloc; b.st[1] = nx; }
        const unsigned old = xb_add(&bar[XB_XSUB(b.x)], 1u);
        const unsigned gen = old / nloc;
        if (old + 1u == (gen + 1u) * nloc) {
            __builtin_amdgcn_fence(__ATOMIC_RELEASE, "agent");
            asm volatile("s_waitcnt vmcnt(0)" ::: "memory");
            const unsigned og = xb_add(&bar[XB_TOP], 1u);
            const unsigned tg = og / nx;
            if (og + 1u == (tg + 1u) * nx) xb_add(&bar[XB_TOPGEN], 1u);
            else XB_SPIN(xb_ld(&bar[XB_TOPGEN]) == tg, bar);
            __builtin_amdgcn_fence(__ATOMIC_ACQUIRE, "agent");
            xb_add(&bar[XB_XGEN(b.x)], 1u);
            asm volatile("s_waitcnt vmcnt(0)" ::: "memory");
        } else {
            XB_SPIN(xb_ld(&bar[XB_XGEN(b.x)]) == gen, bar);
            __builtin_amdgcn_fence(__ATOMIC_ACQUIRE, "agent");
            asm volatile("s_waitcnt vmcnt(0)" ::: "memory");
        }
    }
    __syncthreads();
}

struct Args { const float* in[20]; float* out; unsigned char* ws; int ph_lo, ph_hi; };
constexpr int NPB = 12;
constexpr int NPH = 1 + NBATCH * NPB;

__global__ void __launch_bounds__(512, 2) fwd_kernel(Args args) {
    extern __shared__ __attribute__((aligned(16))) unsigned char lds_raw[];
    LAS unsigned char* lds = (LAS unsigned char*)lds_raw;
    const int G = gridDim.x, bx = blockIdx.x;
    const int NGW = G * 8;
    const int wave = __builtin_amdgcn_readfirstlane((int)threadIdx.x >> 6), gw = bx * 8 + wave;
    unsigned char* ws = args.ws;
    const float* x_prompt = args.in[0]; const float* x_sample = args.in[1];
    bf16* W_in = (bf16*)(ws + WS_WIN); bf16* W_ho = (bf16*)(ws + WS_WHO); bf16* W_ao = (bf16*)(ws + WS_WAO); bf16* W_out = (bf16*)(ws + WS_WOUT);
    bf16* W_xq = (bf16*)(ws + WS_WXQ); bf16* W_xkv = (bf16*)(ws + WS_WXKV); bf16* W_xo = (bf16*)(ws + WS_WXO); bf16* W_f1 = (bf16*)(ws + WS_WF1); bf16* W_f2 = (bf16*)(ws + WS_WF2);
    float* LB = (float*)(ws + WS_LB); float* ROPE = (float*)(ws + WS_ROPE); float* SEGD = (float*)(ws + WS_SEGD); float* SEGL = (float*)(ws + WS_SEGL);
    bf16* MEMN = (bf16*)(ws + WS_MEMN); bf16* KMEM = (bf16*)(ws + WS_KMEM); bf16* VTMEM = (bf16*)(ws + WS_VTMEM); float* LSE = (float*)(ws + WS_LSE);
    bf16* U = (bf16*)(ws + WS_U); bf16* P = (bf16*)(ws + WS_P); float* SS = (float*)(ws + WS_SS);
    cg::grid_group grid = cg::this_grid();
    if (threadIdx.x < 2) *(volatile LAS unsigned*)(lds + LDS_BARST + 4 * threadIdx.x) = 0u;
    __syncthreads();
    XcdBarrier xbar = xcd_barrier_post((unsigned*)(ws + WS_CTL), (volatile LAS unsigned*)(lds + LDS_BARST));

    for (int ph = args.ph_lo; ph < args.ph_hi; ++ph) {
#define TID_INIT unsigned ones_ = ~0u; asm volatile("" : "+s"(ones_)); int tid = wave * 64 + (int)__builtin_amdgcn_mbcnt_hi(ones_, __builtin_amdgcn_mbcnt_lo(ones_, 0u)); asm volatile("" : "+v"(tid)); const int lane = tid & 63; (void)lane;
        if (ph == 0) {
            TID_INIT
            LAS float* scr = (LAS float*)(lds + wave * 16384);
            constexpr int I_IN = 16 * (NIN / 32), I_HO = 16 * 32, I_AO = 8 * 32, I_OUT = 16 * 32, I_XQ = 16 * 32, I_XKV = 16 * 64, I_XO = 16 * 32, I_F1 = 16 * 128, I_F2 = 64 * 32;
            constexpr int NITEMS = I_IN + I_HO + I_AO + I_OUT + I_XQ + I_XKV + I_XO + I_F1 + I_F2;
            for (int it = gw; it < NITEMS; it += NGW) {
                int r = it;
                if (r < I_IN) { p0_transpose_item(args.in[5], 1024, NIN, W_in, args.in[4], scr, r, lane); continue; } r -= I_IN;
                if (r < I_HO) { p0_transpose_item(args.in[8], 1024, 1024, W_ho, nullptr, scr, r, lane); continue; } r -= I_HO;
                if (r < I_AO) { p0_transpose_item(args.in[9], 512, 1024, W_ao, nullptr, scr, r, lane); continue; } r -= I_AO;
                if (r < I_OUT) { p0_transpose_item(args.in[10], 1024, 1024, W_out, nullptr, scr, r, lane); continue; } r -= I_OUT;
                if (r < I_XQ) { p0_transpose_item(args.in[13], 1024, 1024, W_xq, args.in[11], scr, r, lane); continue; } r -= I_XQ;
                if (r < I_XKV) { p0_transpose_item(args.in[14], 1024, 2048, W_xkv, args.in[12], scr, r, lane); continue; } r -= I_XKV;
                if (r < I_XO) { p0_transpose_item(args.in[15], 1024, 1024, W_xo, nullptr, scr, r, lane); continue; } r -= I_XO;
                if (r < I_F1) { p0_transpose_item(args.in[17], 1024, FF, W_f1, args.in[16], scr, r, lane); continue; } r -= I_F1;
                p0_transpose_item(args.in[18], FF, 1024, W_f2, nullptr, scr, r, lane);
            }
            const int gt = bx * 512 + tid, NGT = G * 512;
            for (int i = gt; i < 2048; i += NGT) { const int d = i >> 10, f = i & 1023; const float l0 = args.in[6][d * 2048 + f], l1 = args.in[6][d * 2048 + 1024 + f]; LB[i] = 1.0f / (1.0f + __expf(l1 - l0)); }
            for (int i = gt; i < SEQ * 16; i += NGT) {
                const int pos = i >> 4, fi = i & 15;
                const float invt[16] = {1.0f, 0.44036659598350525f, 0.1939227432012558f, 0.08539710193872452f, 0.03760603070259094f, 0.016560440883040428f, 0.007292664609849453f, 0.0032114461064338684f,
                                        0.0014142135623842478f, 0.0006227724370546639f, 0.00027424818836152554f, 0.00012076973507646471f, 5.3182957344688475e-05f, 2.34199997066753e-05f, 1.0313385246263351e-05f, 4.541670477919979e-06f};
                float inv = invt[0];
#pragma unroll
                for (int k = 1; k < 16; ++k) inv = (fi == k) ? invt[k] : inv;
                const float x = (float)pos * inv;
                const float kq = rintf(x * 0.63661977236758134308f);
                float r = fmaf(-kq, 1.5707855225e+00f, x); r = fmaf(-kq, 1.0804273188e-05f, r); r = fmaf(-kq, 6.0770999344e-11f, r);
                const float r2 = r * r;
                const float sn = r + r * r2 * (-1.0f / 6 + r2 * (1.0f / 120 + r2 * (-1.0f / 5040 + r2 * (1.0f / 362880))));
                const float cn = 1.0f + r2 * (-0.5f + r2 * (1.0f / 24 + r2 * (-1.0f / 720 + r2 * (1.0f / 40320 + r2 * (-1.0f / 3628800)))));
                const int qd = ((int)kq) & 3;
                const float c = (qd == 0) ? cn : (qd == 1) ? -sn : (qd == 2) ? -cn : sn;
                const float s = (qd == 0) ? sn : (qd == 1) ? cn : (qd == 2) ? -sn : -cn;
                ROPE[2 * i] = c; ROPE[2 * i + 1] = s;
            }
            for (int m = gw; m < NSEQ * NMEM; m += NGW) { const float* src = (m < 512) ? args.in[2] + (size_t)m * DM : args.in[3] + (size_t)(m - 512) * DM; norm_row_bf16(src, MEMN + (size_t)m * DM, lane); }
            for (int m = gw; m < BROWS; m += NGW) norm_row_bf16(x_prompt + (size_t)m * DM, U + (size_t)m * DM, lane);
        } else {
            const int b = (ph - 1) / NPB, pp = (ph - 1) % NPB + 1; const int j = pp + (pp >= 7 ? 1 : 0) + (pp >= 10 ? 1 : 0); const bool rep2 = false;
            const float* xb = (b == 0) ? x_prompt : x_sample + (size_t)(b - 1) * BROWS * DM;
            float* hb = args.out + (size_t)b * BROWS * DM;
            bf16* Of = (bf16*)hb; bf16* Ob = Of + (size_t)BROWS * DM;
            if (j == 1) {
                TID_INIT
                { pg8::Gemm g{U, W_in, BROWS, NIN, DM, DM}; pg8::StaticOrder S; S.init(BROWS, NIN, G, bx); pg8::EpiIn E{P, LB, ROPE};
                  pg8::gemm_phase<pg8::EpiIn, true>(lds, g, S, E, tid); }
                if (b == 0) { pg8::Gemm g{MEMN, W_xkv, NSEQ * NMEM, 2048, DM, DM}; pg8::StaticOrder S; S.init(NSEQ * NMEM, 2048, G, (bx + G / 2) % G); pg8::EpiKV E{KMEM, VTMEM};
                  pg8::gemm_phase<pg8::EpiKV, true>(lds, g, S, E, tid); }
            } else if (j == 2) {
                TID_INIT
                for (int it = bx; it < 256; it += G) hgrn_item<1>(lds, P, Of, Ob, SEGL, SEGD, it, tid);
                { const int vcu = (G % 8 == 0) ? (bx % 8) * (G / 8) + bx / 8 : bx;
                  dattn_items(lds, P, LSE, vcu, G, 1536, tid); }
            } else if (j == 3) {
                TID_INIT
                for (int it = bx; it < 256; it += G) hgrn_item<2>(lds, P, Of, Ob, SEGL, SEGD, it, tid);
            } else if (j == 4) {
                TID_INIT
                for (int m = gw; m < BROWS; m += NGW) post_row(P, m, Of + (size_t)m * DM, Ob + (size_t)m * DM, LSE + (size_t)m * 12, args.in[7], U + (size_t)m * DM, lane);
            } else if (j == 5) {
                TID_INIT
                { pg8::Gemm g{U, W_ho, BROWS, DM, DM, DM}; pg8::StaticOrder S; S.init(BROWS, DM, G, bx); pg8::EpiY<1> E{P}; pg8::gemm_phase<pg8::EpiY<1>, true>(lds, g, S, E, tid); }
                { pg8::Gemm g{P + OFF_ATT0, W_ao, BROWS, DM, 512, 512}; pg8::StaticOrder S; S.init(BROWS, DM, G, bx); pg8::EpiY<2> E{P}; pg8::gemm_phase<pg8::EpiY<2>, true>(lds, g, S, E, tid); }
            } else if (j == 6 || j == 10 || j == 13) {
                TID_INIT
                pg8::StaticOrder S; S.init(BROWS, DM, G, bx);
                if (j == 6) { pg8::Gemm g{P + OFF_GH, W_out, BROWS, DM, DM, 1024}; pg8::EpiRes<0> E{xb, nullptr, U, SS}; pg8::gemm_phase<pg8::EpiRes<0>, true>(lds, g, S, E, tid); }
                else if (j == 10) { pg8::Gemm g{P, W_xo, BROWS, DM, DM, DM}; pg8::EpiRes<1> E{nullptr, nullptr, U, SS + (size_t)BROWS * 16}; pg8::gemm_phase<pg8::EpiRes<1>, true>(lds, g, S, E, tid); }
                else { pg8::Gemm g{P, W_f2, BROWS, DM, FF, FF}; pg8::EpiRes<2> E{nullptr, hb, U, SS + (size_t)2 * BROWS * 16}; pg8::gemm_phase<pg8::EpiRes<2>, true>(lds, g, S, E, tid); }
            } else if (j == 7 || j == 11) {
                TID_INIT
                for (int m = gw; m < BROWS; m += NGW) norm_row_bf16(hb + (size_t)m * DM, U + (size_t)m * DM, lane);
            } else if (j == 8) {
                TID_INIT
                pg8::Gemm g{U, W_xq, BROWS, DM, DM, DM}; pg8::StaticOrder S; S.init(BROWS, DM, G, bx); pg8::EpiBf<0> E{P, DM, QSCALE_X, SS}; pg8::gemm_phase<pg8::EpiBf<0>, true>(lds, g, S, E, tid);
            } else if (j == 9) {
                TID_INIT
                for (int it = bx; it < 512; it += G) xattn_item(lds, P, KMEM, VTMEM, b, it, tid);
            } else if (j == 12) {
                TID_INIT
                pg8::Gemm g{U, W_f1, BROWS, FF, DM, DM}; pg8::StaticOrder S; S.init(BROWS, FF, G, bx); pg8::EpiBf<1> E{P, FF, 1.0f, SS + (size_t)BROWS * 16}; pg8::gemm_phase<pg8::EpiBf<1>, true>(lds, g, S, E, tid);
            } else {
                TID_INIT
                for (int m = gw; m < BROWS; m += NGW) final_row_ss(hb + (size_t)m * DM, args.in[19], SS + ((size_t)2 * BROWS + m) * 16, lane);
                if (b + 1 < NBATCH) { const float* xn = x_sample + (size_t)b * BROWS * DM; for (int m = gw; m < BROWS; m += NGW) norm_row_bf16(xn + (size_t)m * DM, U + (size_t)m * DM, lane); }
            }
        }
        if (ph + 1 < args.ph_hi) {
            if (args.ph_lo < 0) { __threadfence(); grid.sync(); }
            xcd_barrier(xbar);
        }
        else __syncthreads();
    }
}

extern "C" void kernel_launch(void* const* d_in, const int* in_sizes, int n_in, void* d_out, int out_size, void* d_ws, size_t ws_size, hipStream_t stream) {
    static int grid = 0;
    if (grid == 0) {
        if (n_in != 20 || ws_size < WS_END) { fprintf(stderr, "kernel_launch: unexpected n_in %d / ws_size %zu\n", n_in, ws_size); grid = -1; return; }
        int dev = 0, cus = 0, per_cu = 0;
        hipGetDevice(&dev); hipDeviceGetAttribute(&cus, hipDeviceAttributeMultiprocessorCount, dev);
        if (hipFuncSetAttribute((const void*)fwd_kernel, hipFuncAttributeMaxDynamicSharedMemorySize, LDS_BYTES) != hipSuccess) { fprintf(stderr, "kernel_launch: hipFuncSetAttribute failed\n"); grid = -1; return; }
        hipOccupancyMaxActiveBlocksPerMultiprocessor(&per_cu, (const void*)fwd_kernel, 512, LDS_BYTES);
        (void)hipGetLastError();
        if (per_cu < 1) per_cu = 1;
        grid = cus;
        fprintf(stderr, "kernel_launch: cus %d per_cu %d grid %d\n", cus, per_cu, grid);
    }
    if (grid < 0) return;
    Args a{};
    for (int i = 0; i < 20; ++i) a.in[i] = (const float*)d_in[i];
    a.out = (float*)d_out; a.ws = (unsigned char*)d_ws;
#if ONE_LAUNCH
    if (hipMemsetAsync((char*)d_ws + WS_CTL, 0, CTL_BYTES, stream) != hipSuccess) { fprintf(stderr, "kernel_launch: memset failed\n"); return; }
    a.ph_lo = 0; a.ph_hi = NPH;
    void* kargs[] = {&a};
    hipError_t e = hipLaunchCooperativeKernel((const void*)fwd_kernel, dim3(grid), dim3(512), kargs, LDS_BYTES, stream);
    if (e != hipSuccess) fprintf(stderr, "cooperative launch failed: %s (grid %d)\n", hipGetErrorString(e), grid);
#else
    for (int ph = 0; ph < NPH; ++ph) {
        a.ph_lo = ph; a.ph_hi = ph + 1;
        hipLaunchKernelGGL(fwd_kernel, dim3(grid), dim3(512), LDS_BYTES, stream, a);
    }
#endif
}
```

```cpp
#include <hip/hip_runtime.h>
#include <hip/hip_cooperative_groups.h>
#include <cstdio>
#include <cstdint>
namespace cg = cooperative_groups;

#ifndef DBL
#define DBL 0
#endif
#ifndef ONE_LAUNCH
#define ONE_LAUNCH 1
#endif

#define DI __device__ __forceinline__
#define LAS __attribute__((address_space(3)))
typedef unsigned short bf16;
typedef short bf16x8 __attribute__((ext_vector_type(8)));
typedef short s16x4 __attribute__((ext_vector_type(4)));
typedef float f32x4 __attribute__((ext_vector_type(4)));
typedef float f32x2 __attribute__((ext_vector_type(2)));
typedef unsigned u32x4 __attribute__((ext_vector_type(4)));
typedef unsigned u32x2 __attribute__((ext_vector_type(2)));

constexpr int DM = 1024, SEQ = 8192, NSEQ = 6, TTOK = NSEQ * SEQ, BROWS = 2 * SEQ  , NBATCH = 3;
constexpr int NIN = 11776, FF = 4096, NMEM = 256;
constexpr int C_Q = 0, C_FF = 1024, C_FB = 2048, C_V = 3072, C_G = 4096, C_ATT = 5120, C_GH = 9728, C_GA = 10752;
constexpr size_t PE1 = (size_t)BROWS * 1024, PE2 = (size_t)BROWS * 512;
constexpr size_t OFF_Q = 0, OFF_FF = PE1, OFF_V = 3 * PE1, OFF_G = 4 * PE1, OFF_ATT0 = 5 * PE1, OFF_GH = 5 * PE1 + 9 * PE2, OFF_GA = OFF_GH + PE1;
constexpr float RMS_EPS = 1e-6f;
constexpr float QSCALE_A = 0.08838834764831845f * 1.4426950408889634f;
constexpr float QSCALE_X = 0.0625f * 1.4426950408889634f;

constexpr size_t MiB = 1u << 20;
constexpr int LDS_BYTES_ = 147456, LDS_BYTES = LDS_BYTES_;
constexpr size_t WS_WIN = 0, WS_WHO = 23 * MiB, WS_WAO = 25 * MiB, WS_WOUT = 26 * MiB, WS_WXQ = 28 * MiB, WS_WXKV = 30 * MiB, WS_WXO = 34 * MiB,
                 WS_WF1 = 36 * MiB, WS_WF2 = 44 * MiB;
constexpr size_t WS_LB = 52 * MiB, WS_ROPE = 52 * MiB + 65536, WS_SEGD = 53 * MiB + 524288, WS_MEMN = 54 * MiB, WS_KMEM = 57 * MiB, WS_VTMEM = 60 * MiB,
                 WS_LSE = 63 * MiB, WS_SEGL = 64 * MiB, WS_U = 80 * MiB, WS_P = 112 * MiB, WS_CTL = 480 * MiB, WS_END = 485 * MiB;
constexpr size_t CTL_BYTES = 16384;
constexpr size_t WS_SS = 481 * MiB;
constexpr int LDS_BARST = LDS_BYTES_ - 64;


DI float bf2f(unsigned short h) { return __uint_as_float((unsigned)h << 16); }
DI unsigned short f2bf(float f) { unsigned u = __float_as_uint(f); return (unsigned short)((u + 0x7fffu + ((u >> 16) & 1u)) >> 16); }
DI unsigned pk2(float lo, float hi) { return (unsigned)f2bf(lo) | ((unsigned)f2bf(hi) << 16); }
DI float lo_f(unsigned u) { return __uint_as_float(u << 16); }
DI float hi_f(unsigned u) { return __uint_as_float(u & 0xffff0000u); }
DI float sigmoidf_(float x) { return __builtin_amdgcn_rcpf(1.0f + __builtin_amdgcn_exp2f(x * -1.4426950408889634f)); }
DI unsigned cvtpk(float lo, float hi) { unsigned r; asm volatile("v_cvt_pk_bf16_f32 %0, %1, %2" : "=v"(r) : "v"(lo), "v"(hi)); return r; }
DI float ex2(float x) { return __builtin_amdgcn_exp2f(x); }
DI float wave_sum(float v) {
#pragma unroll
    for (int o = 1; o < 64; o <<= 1) v += __shfl_xor(v, o);
    return v;
}
#define MFMA16(a, b, c) __builtin_amdgcn_mfma_f32_16x16x32_bf16((a), (b), (c), 0, 0, 0)

namespace pg8 {
constexpr int BM = 256, BK = 64, HALF = 128, HTB = HALF * BK * 2, STAGE_BYTES = 8 * HTB, NXCD = 8, WGM = 2;
DI int lds_byte(int r, int c) { const int st = (r >> 4) * 2 + (c >> 5), rr = r & 15, cc = c & 31, ob = rr * 64 + cc * 2; return st * 1024 + (ob ^ (((ob >> 9) & 1) << 5)); }
DI void stage_rc(int b, int& R, int& C) { const int st = b / 1024, sb = b % 1024, swz = sb ^ (((sb >> 9) & 1) << 5); R = (st >> 1) * 16 + swz / 64; C = (st & 1) * 32 + (swz % 64) / 2; }
DI int perm32(int rho) { const int n = rho >> 4, i = rho & 15; return 8 * (i >> 2) + 4 * n + (i & 3); }
struct Unit { int pm, pn; };
struct Gemm { const bf16* A; const bf16* Bt; int M, N, K, lda; };
struct StaticOrder {
    int nM, nN, nwg, G, c;
    DI void init(int M, int N, int G_, int c_) { nM = M / BM; nN = N / BM; nwg = nM * nN; G = G_; c = c_; }
    DI bool next(int i, Unit& u) const {
        const long L = (long)i * G + c; if (L >= nwg) return false;
        int wgid = (int)L; { const int q = nwg / NXCD, r = nwg % NXCD, xcd = wgid % NXCD, off = wgid / NXCD; wgid = (xcd < r ? xcd * (q + 1) : r * (q + 1) + (xcd - r) * q) + off; }
        const int nig = WGM * nN, gid = wgid / nig, fm = gid * WGM, gsz = (nM - fm) < WGM ? (nM - fm) : WGM;
        u.pm = fm + ((wgid % nig) % gsz); u.pn = (wgid % nig) / gsz; return true;
    }
};
DI unsigned cvt_pk_bf16(float lo, float hi) { unsigned r; asm volatile("v_cvt_pk_bf16_f32 %0, %1, %2" : "=v"(r) : "v"(lo), "v"(hi)); return r; }

template <class Epi, bool ALIGN_EPI>
DI void gemm_phase(LAS unsigned char* lds, const Gemm g, const StaticOrder& S, const Epi& E, const int tid) {
    const int wid = __builtin_amdgcn_readfirstlane(tid >> 6), lane = tid & 63, wr = wid >> 2, wc = wid & 3, fr = lane & 15, fq = lane >> 4;
    const int K = g.K, nt = K / BK;
    unsigned voffA[2], voffB[2];
#pragma unroll
    for (int i = 0; i < 2; ++i) { int R, C; stage_rc(tid * 16 + i * 8192, R, C); const int Rb = Epi::PERM ? ((R & ~31) + perm32(R & 31)) : R;
        voffA[i] = (unsigned)(R * g.lda + C) * 2u; voffB[i] = (unsigned)(Rb * K + C) * 2u; }
    const size_t kstep = (size_t)(BK * 2);
    const size_t hstepA = (size_t)HALF * g.lda * 2, hstepB = (size_t)HALF * K * 2;
    const size_t tstepA = 2 * hstepA, tstepB = 2 * hstepB;
    const unsigned ldsw = (unsigned)wid * 1024u;
    const int aoff = lds_byte(wr * 64 + fr, fq * 8), boff = lds_byte(wc * 32 + fr, fq * 8);
#define PG8_SA(b, h) (((b) * 2 + (h)) * HTB)
#define PG8_SB(b, h) ((4 + (b) * 2 + (h)) * HTB)
#define PG8_STAGE(bufoff, gbase, voff) do { _Pragma("unroll") for (int _i = 0; _i < 2; ++_i) \
        __builtin_amdgcn_global_load_lds((const unsigned*)((const char*)(gbase) + (voff)[_i]), (LAS unsigned*)(lds + (bufoff) + ldsw + _i * 8192), 16, 0, 0); } while (0)
#define PG8_LDA(dst, b, h) do { _Pragma("unroll") for (int m = 0; m < 4; ++m) _Pragma("unroll") for (int k = 0; k < 2; ++k) dst[m][k] = *(const LAS bf16x8*)(lds + PG8_SA(b, h) + aoff + m * 2048 + k * 1024); } while (0)
#define PG8_LDB(dst, b, h) do { _Pragma("unroll") for (int n = 0; n < 2; ++n) _Pragma("unroll") for (int k = 0; k < 2; ++k) dst[n][k] = *(const LAS bf16x8*)(lds + PG8_SB(b, h) + boff + n * 2048 + k * 1024); } while (0)
#define PG8_MMA(ai, bj, At, Bt) do { __builtin_amdgcn_s_setprio(1); _Pragma("unroll") for (int m = 0; m < 4; ++m) _Pragma("unroll") for (int n = 0; n < 2; ++n) _Pragma("unroll") for (int k = 0; k < 2; ++k) \
        acc[ai][bj][m][n] = __builtin_amdgcn_mfma_f32_16x16x32_bf16(Bt[n][k], At[m][k], acc[ai][bj][m][n], 0, 0, 0); __builtin_amdgcn_s_setprio(0); } while (0)
#define PG8_WAIT_V(n) asm volatile("s_waitcnt vmcnt(" #n ")" ::: "memory")
#define PG8_WAIT_L(n) asm volatile("s_waitcnt lgkmcnt(" #n ")" ::: "memory")
#define PG8_BAR __builtin_amdgcn_s_barrier()
#define PG8_SCHED __builtin_amdgcn_sched_barrier(0)
    Unit cur, nxt; int ui = 0;
    if (!S.next(0, cur)) return;
    f32x4 acc[2][2][4][2];
#pragma unroll
    for (int a = 0; a < 2; ++a)
#pragma unroll
        for (int b = 0; b < 2; ++b)
#pragma unroll
            for (int m = 0; m < 4; ++m)
#pragma unroll
                for (int n = 0; n < 2; ++n) acc[a][b][m][n] = (f32x4){0.f, 0.f, 0.f, 0.f};
    bf16x8 At[4][2], B0[2][2], B1[2][2];
    const char* cA = (const char*)g.A + (size_t)cur.pm * tstepA; const char* cB = (const char*)g.Bt + (size_t)cur.pn * tstepB;
    PG8_STAGE(PG8_SB(0, 0), cB, voffB); PG8_STAGE(PG8_SB(0, 1), cB + hstepB, voffB); PG8_STAGE(PG8_SA(0, 0), cA, voffA); PG8_STAGE(PG8_SA(0, 1), cA + hstepA, voffA);
    if (wr == 1) PG8_BAR;
    PG8_WAIT_V(2); PG8_BAR;
    PG8_STAGE(PG8_SB(1, 0), cB + kstep, voffB); PG8_STAGE(PG8_SA(1, 0), cA + kstep, voffA); PG8_STAGE(PG8_SB(1, 1), cB + hstepB + kstep, voffB);
    PG8_WAIT_V(6); PG8_BAR;
    for (;;) {
        const bool has_next = S.next(ui + 1, nxt);
        const char* nA = has_next ? (const char*)g.A + (size_t)nxt.pm * tstepA : cA; const char* nB = has_next ? (const char*)g.Bt + (size_t)nxt.pn * tstepB : cB;
        for (int t = 0; t < nt; t += 2) {
            const bool last = (t == nt - 2);
            const char* a1 = cA + (size_t)(t + 1) * kstep;
            const char* a2 = last ? nA : cA + (size_t)(t + 2) * kstep; const char* b2 = last ? nB : cB + (size_t)(t + 2) * kstep;
            const char* a3 = a2 + kstep; const char* b3 = b2 + kstep;
            PG8_LDB(B0, 0, 0); PG8_LDB(B1, 0, 1); PG8_SCHED; PG8_LDA(At, 0, 0); PG8_STAGE(PG8_SA(1, 1), a1 + hstepA, voffA);
            PG8_WAIT_V(8); PG8_WAIT_L(0); PG8_BAR; PG8_MMA(0, 0, At, B0); PG8_MMA(0, 1, At, B1); PG8_BAR; PG8_SCHED;
            PG8_LDA(At, 0, 1); PG8_STAGE(PG8_SB(0, 0), b2, voffB); PG8_STAGE(PG8_SB(0, 1), b2 + hstepB, voffB); PG8_STAGE(PG8_SA(0, 0), a2, voffA);
            PG8_WAIT_V(8); PG8_WAIT_L(0); PG8_BAR; PG8_MMA(1, 0, At, B0); PG8_MMA(1, 1, At, B1); PG8_BAR; PG8_SCHED;
            PG8_LDB(B0, 1, 0); PG8_LDB(B1, 1, 1); PG8_SCHED; PG8_LDA(At, 1, 0); PG8_STAGE(PG8_SA(0, 1), a2 + hstepA, voffA);
            PG8_WAIT_V(8); PG8_WAIT_L(0); PG8_BAR; PG8_MMA(0, 0, At, B0); PG8_MMA(0, 1, At, B1); PG8_BAR; PG8_SCHED;
            PG8_LDA(At, 1, 1); PG8_STAGE(PG8_SB(1, 0), b3, voffB); PG8_STAGE(PG8_SB(1, 1), b3 + hstepB, voffB); PG8_STAGE(PG8_SA(1, 0), a3, voffA);
            PG8_WAIT_V(8); PG8_WAIT_L(0); PG8_BAR; PG8_MMA(1, 0, At, B0); PG8_MMA(1, 1, At, B1); PG8_BAR; PG8_SCHED;
        }
        if constexpr (ALIGN_EPI) { if (wr == 0) PG8_BAR; }
        E(acc, cur, wr, wc, fr, fq);
        if (!has_next) break;
#pragma unroll
        for (int a = 0; a < 2; ++a)
#pragma unroll
            for (int b = 0; b < 2; ++b)
#pragma unroll
                for (int m = 0; m < 4; ++m)
#pragma unroll
                    for (int n = 0; n < 2; ++n) acc[a][b][m][n] = (f32x4){0.f, 0.f, 0.f, 0.f};
        cur = nxt; cA = nA; cB = nB; ++ui;
        if constexpr (ALIGN_EPI) { if (wr == 1) PG8_BAR; }
    }
    PG8_WAIT_V(0);
    if constexpr (!ALIGN_EPI) { if (wr == 0) PG8_BAR; }
    PG8_BAR;
#undef PG8_SA
#undef PG8_SB
#undef PG8_STAGE
#undef PG8_LDA
#undef PG8_LDB
#undef PG8_MMA
#undef PG8_WAIT_V
#undef PG8_WAIT_L
#undef PG8_BAR
#undef PG8_SCHED
}

struct EpiIn {
    static constexpr bool PERM = true;
    bf16* P; const float* lb; const float* rope;
    DI void operator()(const f32x4 (&acc)[2][2][4][2], const Unit& u, int wr, int wc, int fr, int fq) const {
        const int seg = u.pn >> 1;
        int type, dir = 0;
        if (seg < 2) type = 0; else if (seg < 6) { type = 1; dir = (seg >= 4) ? 1 : 0; } else if (seg < 8) type = 2; else if (seg < 10) type = 0;
        else if (seg < 19) { const int t = (seg - 10) % 3; type = (t == 0) ? 4 : ((t == 1) ? 5 : 2); } else type = 3;
#pragma unroll
        for (int ai = 0; ai < 2; ++ai)
#pragma unroll
            for (int m = 0; m < 4; ++m) {
                const int row = u.pm * BM + ai * HALF + wr * 64 + m * 16 + fr;
                const int c0t = u.pn * BM;
                size_t toff; int pitch, lc;
                if (c0t < C_ATT) { toff = (size_t)(c0t >> 10) * PE1; pitch = 1024; lc = c0t & 1023; }
                else if (c0t < C_GH) { toff = OFF_ATT0 + (size_t)((c0t - C_ATT) >> 9) * PE2; pitch = 512; lc = (c0t - C_ATT) & 511; }
                else { toff = OFF_GH + (size_t)((c0t - C_GH) >> 10) * PE1; pitch = 1024; lc = (c0t - C_GH) & 1023; }
                bf16* rowp = P + toff + (size_t)row * pitch + lc;
#pragma unroll
                for (int bj = 0; bj < 2; ++bj) {
                    const int col0 = u.pn * BM + bj * HALF + wc * 32 + 8 * fq;
                    f32x4 v0 = acc[ai][bj][m][0], v1 = acc[ai][bj][m][1];
                    if (type == 0) {
#pragma unroll
                        for (int i = 0; i < 4; ++i) { v0[i] = v0[i] * sigmoidf_(v0[i]); v1[i] = v1[i] * sigmoidf_(v1[i]); }
                    } else if (type == 1) {
                        const float* lbp = lb + dir * 1024 + (col0 - (C_FF + 1024 * dir));
                        const f32x4 l0 = *(const f32x4*)lbp, l1 = *(const f32x4*)(lbp + 4);
#pragma unroll
                        for (int i = 0; i < 4; ++i) { v0[i] = __logf(l0[i] + (1.0f - l0[i]) * sigmoidf_(v0[i])); v1[i] = __logf(l1[i] + (1.0f - l1[i]) * sigmoidf_(v1[i])); }
                    } else if (type == 3) {
#pragma unroll
                        for (int i = 0; i < 4; ++i) { v0[i] = sigmoidf_(v0[i]); v1[i] = sigmoidf_(v1[i]); }
                    } else if (type == 4 || type == 5) {
                        if (wc == 0) {
                            const int pos = row & (SEQ - 1);
                            const float* rp = rope + ((size_t)pos * 16 + 8 * (fq & 1)) * 2;
                            const f32x4 ca = *(const f32x4*)rp, cb = *(const f32x4*)(rp + 4), cc = *(const f32x4*)(rp + 8), cd = *(const f32x4*)(rp + 12);
                            const float c[8] = {ca[0], ca[2], cb[0], cb[2], cc[0], cc[2], cd[0], cd[2]}, sn[8] = {ca[1], ca[3], cb[1], cb[3], cc[1], cc[3], cd[1], cd[3]};
                            const float sg = (fq < 2) ? -1.0f : 1.0f;
#pragma unroll
                            for (int i = 0; i < 4; ++i) {
                                const float p0 = __shfl_xor(v0[i], 32), p1 = __shfl_xor(v1[i], 32);
                                v0[i] = v0[i] * c[i] + sg * p0 * sn[i]; v1[i] = v1[i] * c[4 + i] + sg * p1 * sn[4 + i];
                            }
                        }
                        if (type == 4) { v0 = v0 * QSCALE_A; v1 = v1 * QSCALE_A; }
                    }
                    u32x4 w; w.x = cvt_pk_bf16(v0[0], v0[1]); w.y = cvt_pk_bf16(v0[2], v0[3]); w.z = cvt_pk_bf16(v1[0], v1[1]); w.w = cvt_pk_bf16(v1[2], v1[3]);
                    *(u32x4*)(rowp + bj * HALF + wc * 32 + 8 * fq) = w;
                }
            }
    }
};
struct EpiKV {
    static constexpr bool PERM = false;
    bf16* Km; bf16* Vt;
    DI void operator()(const f32x4 (&acc)[2][2][4][2], const Unit& u, int wr, int wc, int fr, int fq) const {
#pragma unroll
        for (int ai = 0; ai < 2; ++ai)
#pragma unroll
            for (int m = 0; m < 4; ++m) {
                const int row = u.pm * BM + ai * HALF + wr * 64 + m * 16 + fr;
#pragma unroll
                for (int bj = 0; bj < 2; ++bj)
#pragma unroll
                    for (int n = 0; n < 2; ++n) {
                        const int col0 = u.pn * BM + bj * HALF + wc * 32 + 16 * n + 4 * fq; const f32x4 v = acc[ai][bj][m][n];
                        if (col0 < 1024) { u32x2 w; w.x = cvt_pk_bf16(v[0], v[1]); w.y = cvt_pk_bf16(v[2], v[3]); *(u32x2*)(Km + (size_t)row * 1024 + col0) = w; }
                        else { const int cv = col0 - 1024, head = cv >> 8, d = cv & 255, sq = row >> 8, key = row & 255;
#pragma unroll
                            for (int i = 0; i < 4; ++i) Vt[((size_t)((sq * 4 + head) * 256 + d + i)) * 256 + key] = f2bf(v[i]); }
                    }
            }
    }
};
template <int WHICH> struct EpiY {
    static constexpr bool PERM = true;
    bf16* P;
    DI void operator()(const f32x4 (&acc)[2][2][4][2], const Unit& u, int wr, int wc, int fr, int fq) const {
#pragma unroll
        for (int ai = 0; ai < 2; ++ai)
#pragma unroll
            for (int m = 0; m < 4; ++m) {
                const int row = u.pm * BM + ai * HALF + wr * 64 + m * 16 + fr;
#pragma unroll
                for (int bj = 0; bj < 2; ++bj) {
                    const int col0 = u.pn * BM + bj * HALF + wc * 32 + 8 * fq;
                    bf16* gp = P + OFF_GH + (size_t)row * 1024 + col0;
                    const u32x4 gh = *(const u32x4*)gp;
                    const f32x4 a0 = acc[ai][bj][m][0], a1 = acc[ai][bj][m][1];
                    float o[8];
                    if (WHICH == 1) {
                        o[0] = lo_f(gh.x) * a0[0]; o[1] = hi_f(gh.x) * a0[1]; o[2] = lo_f(gh.y) * a0[2]; o[3] = hi_f(gh.y) * a0[3];
                        o[4] = lo_f(gh.z) * a1[0]; o[5] = hi_f(gh.z) * a1[1]; o[6] = lo_f(gh.w) * a1[2]; o[7] = hi_f(gh.w) * a1[3];
                    } else {
                        const u32x4 ga = *(const u32x4*)(gp + PE1);
                        o[0] = lo_f(gh.x) + lo_f(ga.x) * a0[0]; o[1] = hi_f(gh.x) + hi_f(ga.x) * a0[1]; o[2] = lo_f(gh.y) + lo_f(ga.y) * a0[2]; o[3] = hi_f(gh.y) + hi_f(ga.y) * a0[3];
                        o[4] = lo_f(gh.z) + lo_f(ga.z) * a1[0]; o[5] = hi_f(gh.z) + hi_f(ga.z) * a1[1]; o[6] = lo_f(gh.w) + lo_f(ga.w) * a1[2]; o[7] = hi_f(gh.w) + hi_f(ga.w) * a1[3];
                    }
                    u32x4 w; w.x = cvt_pk_bf16(o[0], o[1]); w.y = cvt_pk_bf16(o[2], o[3]); w.z = cvt_pk_bf16(o[4], o[5]); w.w = cvt_pk_bf16(o[6], o[7]);
                    *(u32x4*)gp = w;
                }
            }
    }
};
template <int MODE> struct EpiRes {
    static constexpr bool PERM = true;
    const float* xin; float* out; bf16* hb16; float* ss;
    DI void operator()(const f32x4 (&acc)[2][2][4][2], const Unit& u, int wr, int wc, int fr, int fq) const {
#pragma unroll
        for (int ai = 0; ai < 2; ++ai)
#pragma unroll
            for (int m = 0; m < 4; ++m) {
                const int row = u.pm * BM + ai * HALF + wr * 64 + m * 16 + fr;
                const size_t off = (size_t)row * DM + u.pn * BM + wc * 32 + 8 * fq;
                float part = 0.f;
#pragma unroll
                for (int bj = 0; bj < 2; ++bj) {
                    f32x4 v0, v1;
                    if (MODE == 0) { v0 = *(const f32x4*)(xin + off + bj * HALF); v1 = *(const f32x4*)(xin + off + bj * HALF + 4); }
                    else { const u32x4 hb = *(const u32x4*)(hb16 + off + bj * HALF); v0 = (f32x4){lo_f(hb.x), hi_f(hb.x), lo_f(hb.y), hi_f(hb.y)}; v1 = (f32x4){lo_f(hb.z), hi_f(hb.z), lo_f(hb.w), hi_f(hb.w)}; }
                    v0 = v0 + acc[ai][bj][m][0]; v1 = v1 + acc[ai][bj][m][1];
                    if (MODE == 2) { *(f32x4*)(out + off + bj * HALF) = v0; *(f32x4*)(out + off + bj * HALF + 4) = v1; }
                    else { u32x4 w; w.x = cvt_pk_bf16(v0[0], v0[1]); w.y = cvt_pk_bf16(v0[2], v0[3]); w.z = cvt_pk_bf16(v1[0], v1[1]); w.w = cvt_pk_bf16(v1[2], v1[3]); *(u32x4*)(hb16 + off + bj * HALF) = w;
                        v0 = (f32x4){lo_f(w.x), hi_f(w.x), lo_f(w.y), hi_f(w.y)}; v1 = (f32x4){lo_f(w.z), hi_f(w.z), lo_f(w.w), hi_f(w.w)}; }
                    part += (v0[0] * v0[0] + v0[1] * v0[1]) + (v0[2] * v0[2] + v0[3] * v0[3]) + (v1[0] * v1[0] + v1[1] * v1[1]) + (v1[2] * v1[2] + v1[3] * v1[3]);
                }
                part += __shfl_xor(part, 16); part += __shfl_xor(part, 32); if (fq == 0) ss[(size_t)row * 16 + u.pn * 4 + wc] = part;
            }
    }
};
template <int ACT> struct EpiBf {
    static constexpr bool PERM = true;
    bf16* O; int ldc; float scale; const float* ss;
    DI void operator()(const f32x4 (&acc)[2][2][4][2], const Unit& u, int wr, int wc, int fr, int fq) const {
#pragma unroll
        for (int ai = 0; ai < 2; ++ai)
#pragma unroll
            for (int m = 0; m < 4; ++m) {
                const int row = u.pm * BM + ai * HALF + wr * 64 + m * 16 + fr;
                bf16* rowp = O + (size_t)row * ldc + u.pn * BM + wc * 32 + 8 * fq;
                float ssum; { const f32x4* sp = (const f32x4*)(ss + (size_t)row * 16); const f32x4 s0 = sp[0], s1 = sp[1], s2 = sp[2], s3 = sp[3];
                    ssum = ((s0[0] + s0[1]) + (s0[2] + s0[3])) + ((s1[0] + s1[1]) + (s1[2] + s1[3])) + ((s2[0] + s2[1]) + (s2[2] + s2[3])) + ((s3[0] + s3[1]) + (s3[2] + s3[3])); }
                const float rstd = rsqrtf(ssum * (1.0f / DM) + RMS_EPS);
                const float sc = (ACT == 1) ? rstd * rstd : rstd * scale;
#pragma unroll
                for (int bj = 0; bj < 2; ++bj) {
                    f32x4 v0 = acc[ai][bj][m][0], v1 = acc[ai][bj][m][1];
                    if (ACT == 1) {
#pragma unroll
                        for (int i = 0; i < 4; ++i) { const float a = fmaxf(v0[i], 0.f), b = fmaxf(v1[i], 0.f); v0[i] = a * a * sc; v1[i] = b * b * sc; }
                    } else { v0 = v0 * sc; v1 = v1 * sc; }
                    u32x4 w; w.x = cvt_pk_bf16(v0[0], v0[1]); w.y = cvt_pk_bf16(v0[2], v0[3]); w.z = cvt_pk_bf16(v1[0], v1[1]); w.w = cvt_pk_bf16(v1[2], v1[3]);
                    *(u32x4*)(rowp + bj * HALF) = w;
                }
            }
    }
};
}

DI void p0_transpose_item(const float* W, int K, int N, bf16* WT, const float* gain, LAS float* scr, int item, int lane) {
    const int nblk = N / 32, kb = item / nblk, nb = item % nblk, k0 = 64 * kb, n0 = 32 * nb;
    float wv[32];
#pragma unroll
    for (int i = 0; i < 32; ++i) { const int kk = 2 * i + (lane >> 5); wv[i] = W[(size_t)(k0 + kk) * N + n0 + (lane & 31)]; }
    if (gain) {
#pragma unroll
        for (int i = 0; i < 32; ++i) wv[i] *= gain[k0 + 2 * i + (lane >> 5)];
    }
#pragma unroll
    for (int i = 0; i < 32; ++i) { const int kk = 2 * i + (lane >> 5); scr[kk * 33 + (lane & 31)] = wv[i]; }
    asm volatile("s_waitcnt lgkmcnt(0)" ::: "memory");
    const int c = lane & 7;
#pragma unroll
    for (int j = 0; j < 4; ++j) { const int n = (lane >> 3) + 8 * j; const LAS float* s = scr + (8 * c) * 33 + n;
        u32x4 o; o.x = pk2(s[0 * 33], s[1 * 33]); o.y = pk2(s[2 * 33], s[3 * 33]); o.z = pk2(s[4 * 33], s[5 * 33]); o.w = pk2(s[6 * 33], s[7 * 33]);
        *(u32x4*)(WT + (size_t)(n0 + n) * K + k0 + 8 * c) = o; }
    asm volatile("s_waitcnt lgkmcnt(0)" ::: "memory");
}
DI void norm_row_bf16(const float* xrow, bf16* orow, int lane) {
    const f32x4* xr = (const f32x4*)xrow + lane;
    f32x4 v[4]; float s = 0.f;
#pragma unroll
    for (int j = 0; j < 4; ++j) { v[j] = xr[64 * j]; s += (v[j].x * v[j].x + v[j].y * v[j].y) + (v[j].z * v[j].z + v[j].w * v[j].w); }
    const float rstd = rsqrtf(wave_sum(s) * (1.f / DM) + RMS_EPS);
    u32x2* o8 = (u32x2*)orow + lane;
#pragma unroll
    for (int j = 0; j < 4; ++j) { u32x2 w; w.x = pk2(v[j].x * rstd, v[j].y * rstd); w.y = pk2(v[j].z * rstd, v[j].w * rstd); o8[64 * j] = w; }
}
DI void final_row_ss(float* hrow, const float* g, const float* ssp, int lane) {
    f32x4* xr = (f32x4*)hrow + lane; const f32x4* gr = (const f32x4*)g + lane;
    const f32x4 s0 = ((const f32x4*)ssp)[0], s1 = ((const f32x4*)ssp)[1], s2 = ((const f32x4*)ssp)[2], s3 = ((const f32x4*)ssp)[3];
    const float ssrow = ((s0[0] + s0[1]) + (s0[2] + s0[3])) + ((s1[0] + s1[1]) + (s1[2] + s1[3])) + ((s2[0] + s2[1]) + (s2[2] + s2[3])) + ((s3[0] + s3[1]) + (s3[2] + s3[3]));
    const float rstd = rsqrtf(ssrow * (1.f / DM) + RMS_EPS);
    f32x4 v[4];
#pragma unroll
    for (int j = 0; j < 4; ++j) v[j] = xr[64 * j];
#pragma unroll
    for (int j = 0; j < 4; ++j) xr[64 * j] = v[j] * rstd * gr[64 * j];
}
DI void final_row(float* hrow, const float* g, int lane) {
    f32x4* xr = (f32x4*)hrow + lane; const f32x4* gr = (const f32x4*)g + lane;
    f32x4 v[4]; float s = 0.f;
#pragma unroll
    for (int j = 0; j < 4; ++j) { v[j] = xr[64 * j]; s += (v[j].x * v[j].x + v[j].y * v[j].y) + (v[j].z * v[j].z + v[j].w * v[j].w); }
    const float rstd = rsqrtf(wave_sum(s) * (1.f / DM) + RMS_EPS);
#pragma unroll
    for (int j = 0; j < 4; ++j) xr[64 * j] = v[j] * rstd * gr[64 * j];
}

constexpr int HG_QD = 0, HG_KD = 17408, HG_QS = 34816, HG_K0E = 52224, HG_KST = 60928, HG_VT = 79360, HG_AM = 97792, HG_TOT = 107008, HG_DL = 109056;
template <int PASS>
DI void hgrn_item(LAS unsigned char* lds, const bf16* Pb, bf16* Of, bf16* Ob, float* segL, float* segD, int item, int tid) {
    const int lane = tid & 63, w = __builtin_amdgcn_readfirstlane(tid >> 6), r16 = lane & 15, q4 = lane >> 4;
    const int sg = item & 7, dir = (item >> 3) & 1, head = (item >> 4) & 7, sq = item >> 7;
    if (PASS == 1 && sg == 7) return;
    const int kcol = tid & 127, qtr = tid >> 7;
    const char* ubq = (const char*)(Pb + OFF_Q + (size_t)sq * SEQ * 1024 + head * 128);
    const char* ubf = (const char*)(Pb + OFF_FF + (size_t)dir * PE1 + (size_t)sq * SEQ * 1024 + head * 128);
    const char* ubv = (const char*)(Pb + OFF_V + (size_t)sq * SEQ * 1024 + head * 128);
    const unsigned voff0 = (unsigned)kcol * 2u + (unsigned)(dir ? 63 - 16 * qtr : 16 * qtr) * 2048u;
    const int vstep = dir ? -2048 : 2048;
    bf16* Od = (dir ? Ob : Of) + (size_t)sq * SEQ * DM + head * 128 + 16 * w + r16;
    f32x4 S[8];
#pragma unroll
    for (int kt = 0; kt < 8; ++kt) S[kt] = (f32x4){0.f, 0.f, 0.f, 0.f};
    if (PASS == 2) {
        for (int s2 = 0; s2 < sg; ++s2) {
            const int it2 = item - sg + s2;
            const float* Lp = segL + (size_t)it2 * 16384 + (size_t)(w * 8) * 256 + lane;
            const float* Dp = segD + (size_t)it2 * 128 + 4 * q4;
#pragma unroll
            for (int kt = 0; kt < 8; ++kt) { const f32x4 d = *(const f32x4*)(Dp + 16 * kt);
#pragma unroll
                for (int i = 0; i < 4; ++i) S[kt][i] = d[i] * S[kt][i] + Lp[(kt * 4 + i) * 64]; }
        }
    }
    float bseg = 0.f;
    LAS float* TOT = (LAS float*)(lds + HG_TOT); LAS float* DL = (LAS float*)(lds + HG_DL);
    unsigned short qv[16], vv[16], lfn[16];
#define HG_LOAD(pp) do { const size_t cb_ = (size_t)(dir ? (SEQ - 64 * ((pp) + 1)) : (64 * (pp))) * 2048;     \
        const char* cq_ = ubq + cb_; const char* cf_ = ubf + cb_; const char* cv_ = ubv + cb_; \
        _Pragma("unroll") for (int i = 0; i < 16; ++i) { const unsigned vo_ = voff0 + (unsigned)(vstep * i); \
            lfn[i] = *(const bf16*)(cf_ + vo_); vv[i] = *(const bf16*)(cv_ + vo_); if (PASS == 2) qv[i] = *(const bf16*)(cq_ + vo_); } } while (0)
    HG_LOAD(sg * 16);
    for (int j = 0; j < 16; ++j) {
        const int p = sg * 16 + j;
        float cs[16]; unsigned short lfr[16];
#pragma unroll
        for (int i = 0; i < 16; ++i) lfr[i] = lfn[i];
        { float run = 0.f;
#pragma unroll
          for (int i = 0; i < 16; ++i) { run += bf2f(lfr[i]); cs[i] = run; } }
        TOT[qtr * 128 + kcol] = cs[15];
        { u32x4 a, b; a.x = vv[0] | ((unsigned)vv[1] << 16); a.y = vv[2] | ((unsigned)vv[3] << 16); a.z = vv[4] | ((unsigned)vv[5] << 16); a.w = vv[6] | ((unsigned)vv[7] << 16);
          b.x = vv[8] | ((unsigned)vv[9] << 16); b.y = vv[10] | ((unsigned)vv[11] << 16); b.z = vv[12] | ((unsigned)vv[13] << 16); b.w = vv[14] | ((unsigned)vv[15] << 16);
          LAS u32x4* vp = (LAS u32x4*)(lds + HG_VT + kcol * 144 + qtr * 32); vp[0] = a; vp[1] = b; }
        __syncthreads();
        const float t0 = TOT[kcol], t1 = TOT[128 + kcol], t2 = TOT[256 + kcol], t3 = TOT[384 + kcol];
        const float off = (qtr > 0 ? t0 : 0.f) + (qtr > 1 ? t1 : 0.f) + (qtr > 2 ? t2 : 0.f);
        const float r1 = t0 + t1, blast = (t0 + t1) + (t2 + t3);
        const float rblk = (qtr >= 2) ? r1 : 0.f;
        if (qtr == 0) { DL[kcol] = ex2(blast * 1.4426950408889634f); bseg += blast; }
        unsigned ks[8];
        constexpr float L2E = 1.4426950408889634f;
        const float er1 = ex2(r1 * L2E), ebl1 = ex2((blast - r1) * L2E);
#pragma unroll
        for (int i = 0; i < 16; i += 2) {
            float kk[2], bb[2], e1[2], e2[2], eks[2], e3[2];
#pragma unroll
            for (int e = 0; e < 2; ++e) {
                bb[e] = off + cs[i + e]; kk[e] = 1.0f - ex2(bf2f(lfr[i + e]) * L2E);
                if (qtr < 2) {
                    e1[e] = ex2(bb[e] * L2E); e2[e] = ex2(fminf(-bb[e], 80.f) * L2E); e3[e] = ex2((r1 - bb[e]) * L2E); eks[e] = e3[e] * ebl1;
                } else {
                    e1[e] = ex2((bb[e] - r1) * L2E); e2[e] = ex2(fminf(r1 - bb[e], 80.f) * L2E); e3[e] = 0.f; eks[e] = ex2((blast - bb[e]) * L2E);
                }
            }
            ks[i >> 1] = cvtpk(kk[0] * eks[0], kk[1] * eks[1]);
            if (PASS == 2) {
                const float q0 = bf2f(qv[i]), q1 = bf2f(qv[i + 1]);
                const int tau = 16 * qtr + i;
                const unsigned wqd = cvtpk(q0 * e1[0], q1 * e1[1]);
                const unsigned wkd = cvtpk(kk[0] * e2[0], kk[1] * e2[1]);
                const unsigned wqs = (qtr < 2) ? wqd : cvtpk(q0 * e1[0] * er1, q1 * e1[1] * er1);
                *(LAS bf16*)(lds + HG_QD + tau * 272 + kcol * 2) = (bf16)(wqd & 0xffffu); *(LAS bf16*)(lds + HG_QD + (tau + 1) * 272 + kcol * 2) = (bf16)(wqd >> 16);
                *(LAS bf16*)(lds + HG_KD + tau * 272 + kcol * 2) = (bf16)(wkd & 0xffffu); *(LAS bf16*)(lds + HG_KD + (tau + 1) * 272 + kcol * 2) = (bf16)(wkd >> 16);
                *(LAS bf16*)(lds + HG_QS + tau * 272 + kcol * 2) = (bf16)(wqs & 0xffffu); *(LAS bf16*)(lds + HG_QS + (tau + 1) * 272 + kcol * 2) = (bf16)(wqs >> 16);
                if (qtr < 2) { const unsigned wk0 = cvtpk(kk[0] * e3[0], kk[1] * e3[1]);
                    *(LAS bf16*)(lds + HG_K0E + tau * 272 + kcol * 2) = (bf16)(wk0 & 0xffffu); *(LAS bf16*)(lds + HG_K0E + (tau + 1) * 272 + kcol * 2) = (bf16)(wk0 >> 16); }
            }
        }
        { LAS u32x4* kp = (LAS u32x4*)(lds + HG_KST + kcol * 144 + qtr * 32); kp[0] = (u32x4){ks[0], ks[1], ks[2], ks[3]}; kp[1] = (u32x4){ks[4], ks[5], ks[6], ks[7]}; }
        __syncthreads();
        if (j + 1 < 16) HG_LOAD(p + 1);
        if (PASS == 2) {
            const int ti = w >> 1;
#pragma unroll
            for (int e = 0; e < 2; ++e) {
                const int sj = 2 * (w & 1) + e;
                f32x4 a4 = (f32x4){0.f, 0.f, 0.f, 0.f};
                if (sj <= ti) {
                    const int bsrc = (ti >= 2 && sj < 2) ? HG_K0E : HG_KD;
                    bf16x8 fa[4], fb[4];
#pragma unroll
                    for (int st = 0; st < 4; ++st) {
                        fa[st] = *(const LAS bf16x8*)(lds + HG_QD + (16 * ti + r16) * 272 + (32 * st + 8 * q4) * 2);
                        fb[st] = *(const LAS bf16x8*)(lds + bsrc + (16 * sj + r16) * 272 + (32 * st + 8 * q4) * 2);
                    }
                    __builtin_amdgcn_sched_barrier(0);
#pragma unroll
                    for (int st = 0; st < 4; ++st) a4 = MFMA16(fa[st], fb[st], a4);
                    __builtin_amdgcn_sched_barrier(0);
                }
#pragma unroll
                for (int i = 0; i < 4; ++i) { const int t = 16 * ti + 4 * q4 + i, s = 16 * sj + r16; *(LAS bf16*)(lds + HG_AM + t * 144 + s * 2) = f2bf(s <= t ? a4[i] : 0.f); }
            }
            __syncthreads();
        }
        bf16x8 bv[2];
#pragma unroll
        for (int st = 0; st < 2; ++st) bv[st] = *(const LAS bf16x8*)(lds + HG_VT + (16 * w + r16) * 144 + (32 * st + 8 * q4) * 2);
        if (PASS == 2) {
            bf16x8 sb[4];
#pragma unroll
            for (int k2 = 0; k2 < 4; ++k2) { u32x4 pz; pz.x = pk2(S[2 * k2][0], S[2 * k2][1]); pz.y = pk2(S[2 * k2][2], S[2 * k2][3]); pz.z = pk2(S[2 * k2 + 1][0], S[2 * k2 + 1][1]); pz.w = pk2(S[2 * k2 + 1][2], S[2 * k2 + 1][3]);
                sb[k2] = __builtin_bit_cast(bf16x8, pz); }
#pragma unroll
            for (int ti = 0; ti < 4; ++ti) {
                f32x4 o4 = (f32x4){0.f, 0.f, 0.f, 0.f};
                bf16x8 fam[2]; s16x4 ql[4], qh[4];
#pragma unroll
                for (int st = 0; st < 2; ++st) fam[st] = *(const LAS bf16x8*)(lds + HG_AM + (16 * ti + r16) * 144 + (32 * st + 8 * q4) * 2);
#pragma unroll
                for (int k2 = 0; k2 < 4; ++k2) {
                    ql[k2] = *(const LAS s16x4*)(lds + HG_QS + (16 * ti + r16) * 272 + (32 * k2 + 4 * q4) * 2);
                    qh[k2] = *(const LAS s16x4*)(lds + HG_QS + (16 * ti + r16) * 272 + (32 * k2 + 16 + 4 * q4) * 2);
                }
                __builtin_amdgcn_sched_barrier(0);
#pragma unroll
                for (int st = 0; st < 2; ++st) o4 = MFMA16(fam[st], bv[st], o4);
#pragma unroll
                for (int k2 = 0; k2 < 4; ++k2) o4 = MFMA16(__builtin_shufflevector(ql[k2], qh[k2], 0, 1, 2, 3, 4, 5, 6, 7), sb[k2], o4);
                __builtin_amdgcn_sched_barrier(0);
#pragma unroll
                for (int i = 0; i < 4; ++i) { const int tau = 16 * ti + 4 * q4 + i; const int tok = dir ? (SEQ - 1 - 64 * p - tau) : (64 * p + tau); Od[(size_t)tok * DM] = f2bf(o4[i]); }
            }
        }
#pragma unroll
        for (int kh = 0; kh < 2; ++kh) {
            bf16x8 fk[4][2]; f32x4 dd[4];
#pragma unroll
            for (int k4 = 0; k4 < 4; ++k4) { const int kt = 4 * kh + k4;
                dd[k4] = *(const LAS f32x4*)(lds + HG_DL + (16 * kt + 4 * q4) * 4);
#pragma unroll
                for (int st = 0; st < 2; ++st) fk[k4][st] = *(const LAS bf16x8*)(lds + HG_KST + (16 * kt + r16) * 144 + (32 * st + 8 * q4) * 2); }
            __builtin_amdgcn_sched_barrier(0);
#pragma unroll
            for (int k4 = 0; k4 < 4; ++k4) { const int kt = 4 * kh + k4; S[kt] = S[kt] * dd[k4]; }
#pragma unroll
            for (int st = 0; st < 2; ++st)
#pragma unroll
                for (int k4 = 0; k4 < 4; ++k4) { const int kt = 4 * kh + k4; S[kt] = MFMA16(fk[k4][st], bv[st], S[kt]); }
            __builtin_amdgcn_sched_barrier(0);
        }
        __syncthreads();
    }
    if (PASS == 1) {
        float* Lp = segL + (size_t)item * 16384 + (size_t)(w * 8) * 256 + lane;
#pragma unroll
        for (int kt = 0; kt < 8; ++kt)
#pragma unroll
            for (int i = 0; i < 4; ++i) Lp[(kt * 4 + i) * 64] = S[kt][i];
        if (qtr == 0) segD[(size_t)item * 128 + kcol] = __expf(bseg);
    }
}

constexpr int DA_K = 0, DA_V = 69632;
typedef short v4i16_t __attribute__((ext_vector_type(4)));
DI s16x4 vtr(LAS unsigned char* p) { return __builtin_bit_cast(s16x4, __builtin_amdgcn_ds_read_tr16_b64_v4i16((LAS v4i16_t*)p)); }
struct DaIdx { int head, g, sq, dil, L, res, m0, qcol; };
DI DaIdx da_index(int item) {
    DaIdx d; const int idx = item & 63; d.head = (item >> 6) & 3; d.g = (item >> 8) % 3; d.sq = (item >> 8) / 3;
    d.dil = (d.g == 0) ? 1 : ((d.g == 1) ? 4 : 16); d.L = SEQ / d.dil; const int tpr = d.L / 128; d.res = idx / tpr; d.m0 = 128 * (idx % tpr);
    d.qcol = 128 * d.head; return d;
}
DI void da_load(const bf16* Pb, int item, int tid, u32x4 (&kreg)[8], u32x4 (&vreg)[8], bf16x8 (&qf)[4]) {
    const DaIdx d = da_index(item);
    const int lane = tid & 63, w = tid >> 6, r16 = lane & 15, q4 = lane >> 4;
    const bf16* rowbase = Pb + OFF_ATT0 + (size_t)(3 * d.g) * PE2 + (size_t)d.sq * SEQ * 512;
    const bf16* qrow = rowbase + (size_t)((d.m0 + 16 * w + r16) * d.dil + d.res) * 512 + d.qcol;
#pragma unroll
    for (int st = 0; st < 4; ++st) qf[st] = *(const bf16x8*)(qrow + 32 * st + 8 * q4);
#pragma unroll
    for (int it = 0; it < 8; ++it) {
        const int e = it * 512 + tid, key = e >> 4, ch = e & 15, m = d.m0 - 64 + key;
        kreg[it] = (u32x4){0u, 0u, 0u, 0u}; vreg[it] = kreg[it];
        if (m >= 0 && m < d.L) { const bf16* rp = rowbase + (size_t)(m * d.dil + d.res) * 512 + d.qcol + ch * 8; kreg[it] = *(const u32x4*)(rp + PE2); vreg[it] = *(const u32x4*)(rp + 2 * PE2); }
    }
}
DI void dattn_items(LAS unsigned char* lds, bf16* Pb, float* lse, int first, int stride, int nitems, int tid) {
    const int lane = tid & 63, w = __builtin_amdgcn_readfirstlane(tid >> 6), r16 = lane & 15, q4 = lane >> 4;
    u32x4 kreg[8], vreg[8]; bf16x8 qn[4];
    if (first < nitems) da_load(Pb, first, tid, kreg, vreg, qn);
    for (int item = first; item < nitems; item += stride) {
    const DaIdx d = da_index(item);
    const int head = d.head, g = d.g, sq = d.sq, dil = d.dil, L = d.L, res = d.res, m0 = d.m0, qcol = d.qcol;
    bf16* rowbase = Pb + OFF_ATT0 + (size_t)(3 * g) * PE2 + (size_t)sq * SEQ * 512;
    const int mq = m0 + 16 * w + r16;
    bf16* qrow = rowbase + (size_t)(mq * dil + res) * 512 + qcol;
    bf16x8 qf[4];
#pragma unroll
    for (int st = 0; st < 4; ++st) qf[st] = qn[st];
#pragma unroll
    for (int it = 0; it < 8; ++it) {
        const int e = it * 512 + tid, key = e >> 4, ch = e & 15;
        *(LAS u32x4*)(lds + DA_K + key * 272 + ch * 16) = kreg[it];
        *(LAS u32x4*)(lds + DA_V + key * 288 + ch * 16) = vreg[it];
    }
    __syncthreads();
    if (item + stride < nitems) da_load(Pb, item + stride, tid, kreg, vreg, qn);
    f32x4 sc[9];
    float mx = -1e30f;
#pragma unroll
    for (int kt = 0; kt < 9; ++kt) {
        f32x4 a4 = (f32x4){0.f, 0.f, 0.f, 0.f};
        bf16x8 fa[4];
#pragma unroll
        for (int st = 0; st < 4; ++st) fa[st] = *(const LAS bf16x8*)(lds + DA_K + (16 * w + 16 * kt + r16) * 272 + (32 * st + 8 * q4) * 2);
        __builtin_amdgcn_sched_barrier(0);
#pragma unroll
        for (int st = 0; st < 4; ++st) a4 = MFMA16(fa[st], qf[st], a4);
        __builtin_amdgcn_sched_barrier(0);
#pragma unroll
        for (int i = 0; i < 4; ++i) { const int mk = m0 - 64 + 16 * w + 16 * kt + 4 * q4 + i; const int dd = mk - mq;
            const bool ok = (mk >= 0) && (mk < L) && (dd <= 64) && (dd >= -64); a4[i] = ok ? a4[i] : -1e30f; mx = fmaxf(mx, a4[i]); }
        sc[kt] = a4;
    }
    mx = fmaxf(mx, __shfl_xor(mx, 16)); mx = fmaxf(mx, __shfl_xor(mx, 32));
    float sum = 0.f;
#pragma unroll
    for (int kt = 0; kt < 9; ++kt)
#pragma unroll
        for (int i = 0; i < 4; ++i) { const float pv = __builtin_amdgcn_exp2f(sc[kt][i] - mx); sc[kt][i] = pv; sum += pv; }
    sum += __shfl_xor(sum, 16); sum += __shfl_xor(sum, 32);
    bf16x8 pb[5];
#pragma unroll
    for (int pp = 0; pp < 5; ++pp) { u32x4 pz; pz.x = pk2(sc[2 * pp][0], sc[2 * pp][1]); pz.y = pk2(sc[2 * pp][2], sc[2 * pp][3]);
        if (pp < 4) { pz.z = pk2(sc[2 * pp + 1][0], sc[2 * pp + 1][1]); pz.w = pk2(sc[2 * pp + 1][2], sc[2 * pp + 1][3]); } else { pz.z = 0u; pz.w = 0u; }
        pb[pp] = __builtin_bit_cast(bf16x8, pz); }
    const float rs = 1.0f / sum;
#pragma unroll
    for (int dt = 0; dt < 8; ++dt) {
        f32x4 o4 = (f32x4){0.f, 0.f, 0.f, 0.f};
        s16x4 vl[5], vh[5];
#pragma unroll
        for (int pp = 0; pp < 5; ++pp) {
            LAS unsigned char* vb = lds + DA_V + (16 * w + 32 * pp + 4 * q4 + (r16 >> 2)) * 288 + (16 * dt + 4 * (r16 & 3)) * 2;
            vl[pp] = vtr(vb);
            vh[pp] = vtr(pp < 4 ? vb + 16 * 288 : vb);
        }
        __builtin_amdgcn_sched_barrier(0);
#pragma unroll
        for (int pp = 0; pp < 5; ++pp) o4 = MFMA16(__builtin_shufflevector(vl[pp], vh[pp], 0, 1, 2, 3, 4, 5, 6, 7), pb[pp], o4);
        __builtin_amdgcn_sched_barrier(0);
        u32x2 wv; wv.x = pk2(o4[0] * rs, o4[1] * rs); wv.y = pk2(o4[2] * rs, o4[3] * rs);
        *(u32x2*)(qrow + 16 * dt + 4 * q4) = wv;
    }
    if (q4 == 0) lse[((size_t)sq * SEQ + (size_t)(mq * dil + res)) * 12 + g * 4 + head] = mx + __builtin_amdgcn_logf(sum);
    __syncthreads();
    }
}

DI void xattn_item(LAS unsigned char* lds, bf16* Qx, const bf16* Kmem, const bf16* Vtmem, int b, int item, int tid) {
    const int lane = tid & 63, w = __builtin_amdgcn_readfirstlane(tid >> 6), r16 = lane & 15, q4 = lane >> 4;
    const int qt = item & 63, head = (item >> 6) & 3, sq = item >> 8, mseq = 2 * b + sq;
    const bf16* Kg = Kmem + (size_t)mseq * 256 * 1024 + head * 256;
    const bf16* Vg = Vtmem + (size_t)(mseq * 4 + head) * 256 * 256;
    bf16* qrow = Qx + ((size_t)sq * SEQ + 128 * qt + 16 * w + r16) * DM + head * 256;
    bf16x8 qf[8];
#pragma unroll
    for (int st = 0; st < 8; ++st) qf[st] = *(const bf16x8*)(qrow + 32 * st + 8 * q4);
    {
        u32x4 kreg[16];
#pragma unroll
        for (int it = 0; it < 16; ++it) { const int e = it * 512 + tid, key = e >> 5, ch = e & 31; kreg[it] = *(const u32x4*)(Kg + (size_t)key * 1024 + ch * 8); }
#pragma unroll
        for (int it = 0; it < 16; ++it) { const int e = it * 512 + tid, key = e >> 5, ch = e & 31; *(LAS u32x4*)(lds + key * 528 + ch * 16) = kreg[it]; }
    }
    __syncthreads();
    f32x4 sc[16]; float mx = -1e30f;
#define XA_KREAD(dst, kt_) _Pragma("unroll") for (int st = 0; st < 8; ++st) dst[st] = *(const LAS bf16x8*)(lds + (16 * (kt_) + r16) * 528 + (32 * st + 8 * q4) * 2)
#define XA_TILE(src, kt_) do { f32x4 a4 = (f32x4){0.f, 0.f, 0.f, 0.f}; _Pragma("unroll") for (int st = 0; st < 8; ++st) a4 = MFMA16(src[st], qf[st], a4); \
        _Pragma("unroll") for (int i = 0; i < 4; ++i) mx = fmaxf(mx, a4[i]); sc[kt_] = a4; } while (0)
    {
#pragma unroll
        for (int kt = 0; kt < 16; ++kt) {
            bf16x8 fa[8];
            XA_KREAD(fa, kt); __builtin_amdgcn_sched_barrier(0);
            XA_TILE(fa, kt); __builtin_amdgcn_sched_barrier(0);
        }
    }
    mx = fmaxf(mx, __shfl_xor(mx, 16)); mx = fmaxf(mx, __shfl_xor(mx, 32));
    float sum = 0.f;
#pragma unroll
    for (int kt = 0; kt < 16; ++kt)
#pragma unroll
        for (int i = 0; i < 4; ++i) { const float pv = __builtin_amdgcn_exp2f(sc[kt][i] - mx); sc[kt][i] = pv; sum += pv; }
    sum += __shfl_xor(sum, 16); sum += __shfl_xor(sum, 32);
    bf16x8 pb[8];
#pragma unroll
    for (int pp = 0; pp < 8; ++pp) { u32x4 pz; pz.x = pk2(sc[2 * pp][0], sc[2 * pp][1]); pz.y = pk2(sc[2 * pp][2], sc[2 * pp][3]); pz.z = pk2(sc[2 * pp + 1][0], sc[2 * pp + 1][1]); pz.w = pk2(sc[2 * pp + 1][2], sc[2 * pp + 1][3]);
        pb[pp] = __builtin_bit_cast(bf16x8, pz); }
    {
        u32x4 vreg[16];
#pragma unroll
        for (int it = 0; it < 16; ++it) { const int e = it * 512 + tid, d = e >> 5, ch = e & 31; vreg[it] = *(const u32x4*)(Vg + (size_t)d * 256 + ch * 8); }
        __syncthreads();
#pragma unroll
        for (int it = 0; it < 16; ++it) { const int e = it * 512 + tid, d = e >> 5, ch = e & 31; *(LAS u32x4*)(lds + d * 528 + ch * 16) = vreg[it]; }
    }
    __syncthreads();
    const float rs = __builtin_amdgcn_rcpf(sum);
#define XA_VREAD(dst, dt_) _Pragma("unroll") for (int pp = 0; pp < 8; ++pp) { dst[2 * pp] = *(const LAS s16x4*)(lds + (16 * (dt_) + r16) * 528 + (32 * pp + 4 * q4) * 2); \
        dst[2 * pp + 1] = *(const LAS s16x4*)(lds + (16 * (dt_) + r16) * 528 + (32 * pp + 16 + 4 * q4) * 2); }
#define XA_OTILE(src, dt_) do { f32x4 o4 = (f32x4){0.f, 0.f, 0.f, 0.f}; _Pragma("unroll") for (int pp = 0; pp < 8; ++pp) o4 = MFMA16(__builtin_shufflevector(src[2 * pp], src[2 * pp + 1], 0, 1, 2, 3, 4, 5, 6, 7), pb[pp], o4); \
        u32x2 wv; wv.x = cvtpk(o4[0] * rs, o4[1] * rs); wv.y = cvtpk(o4[2] * rs, o4[3] * rs); *(u32x2*)(qrow + 16 * (dt_) + 4 * q4) = wv; } while (0)
    {
#pragma unroll
        for (int dt = 0; dt < 16; ++dt) {
            s16x4 va[16];
            XA_VREAD(va, dt); __builtin_amdgcn_sched_barrier(0);
            XA_OTILE(va, dt); __builtin_amdgcn_sched_barrier(0);
        }
    }
    __syncthreads();
}

DI void post_row(bf16* P, int m, const bf16* ofr, const bf16* obr, const float* lser, const float* gn, bf16* Urow, int lane) {
    bf16* arow = P + OFF_ATT0 + (size_t)m * 512 + 8 * lane; const bf16* grow = P + OFF_G + (size_t)m * 1024;
    { const int h = lane >> 4; const float l0 = lser[h], l1 = lser[4 + h], l2 = lser[8 + h]; const float mxl = fmaxf(l0, fmaxf(l1, l2));
      float w0 = __builtin_amdgcn_exp2f(l0 - mxl), w1 = __builtin_amdgcn_exp2f(l1 - mxl), w2 = __builtin_amdgcn_exp2f(l2 - mxl); const float rs = 1.0f / (w0 + w1 + w2); w0 *= rs; w1 *= rs; w2 *= rs;
      const u32x4 a = *(const u32x4*)arow, b = *(const u32x4*)(arow + 3 * PE2), c = *(const u32x4*)(arow + 6 * PE2);
      u32x4 o;
      o.x = pk2(w0 * lo_f(a.x) + w1 * lo_f(b.x) + w2 * lo_f(c.x), w0 * hi_f(a.x) + w1 * hi_f(b.x) + w2 * hi_f(c.x));
      o.y = pk2(w0 * lo_f(a.y) + w1 * lo_f(b.y) + w2 * lo_f(c.y), w0 * hi_f(a.y) + w1 * hi_f(b.y) + w2 * hi_f(c.y));
      o.z = pk2(w0 * lo_f(a.z) + w1 * lo_f(b.z) + w2 * lo_f(c.z), w0 * hi_f(a.z) + w1 * hi_f(b.z) + w2 * hi_f(c.z));
      o.w = pk2(w0 * lo_f(a.w) + w1 * lo_f(b.w) + w2 * lo_f(c.w), w0 * hi_f(a.w) + w1 * hi_f(b.w) + w2 * hi_f(c.w));
      *(u32x4*)arow = o; }
    { float o[16];
#pragma unroll
      for (int hlf = 0; hlf < 2; ++hlf) { const u32x4 a = *(const u32x4*)(ofr + 16 * lane + 8 * hlf), b = *(const u32x4*)(obr + 16 * lane + 8 * hlf);
          o[8 * hlf + 0] = lo_f(a.x) + lo_f(b.x); o[8 * hlf + 1] = hi_f(a.x) + hi_f(b.x); o[8 * hlf + 2] = lo_f(a.y) + lo_f(b.y); o[8 * hlf + 3] = hi_f(a.y) + hi_f(b.y);
          o[8 * hlf + 4] = lo_f(a.z) + lo_f(b.z); o[8 * hlf + 5] = hi_f(a.z) + hi_f(b.z); o[8 * hlf + 6] = lo_f(a.w) + lo_f(b.w); o[8 * hlf + 7] = hi_f(a.w) + hi_f(b.w); }
      float ss = 0.f;
#pragma unroll
      for (int i = 0; i < 16; ++i) ss += o[i] * o[i];
      ss += __shfl_xor(ss, 1); ss += __shfl_xor(ss, 2); ss += __shfl_xor(ss, 4);
      const float rstd = rsqrtf(ss * (1.0f / 128.0f) + RMS_EPS);
      const int vc = (16 * lane) & 127;
#pragma unroll
      for (int hlf = 0; hlf < 2; ++hlf) { const u32x4 gsl = *(const u32x4*)(grow + 16 * lane + 8 * hlf);
          const f32x4 g0 = *(const f32x4*)(gn + vc + 8 * hlf), g1 = *(const f32x4*)(gn + vc + 8 * hlf + 4);
          u32x4 wv;
          wv.x = pk2(o[8 * hlf + 0] * rstd * g0[0] * lo_f(gsl.x), o[8 * hlf + 1] * rstd * g0[1] * hi_f(gsl.x));
          wv.y = pk2(o[8 * hlf + 2] * rstd * g0[2] * lo_f(gsl.y), o[8 * hlf + 3] * rstd * g0[3] * hi_f(gsl.y));
          wv.z = pk2(o[8 * hlf + 4] * rstd * g1[0] * lo_f(gsl.z), o[8 * hlf + 5] * rstd * g1[1] * hi_f(gsl.z));
          wv.w = pk2(o[8 * hlf + 6] * rstd * g1[2] * lo_f(gsl.w), o[8 * hlf + 7] * rstd * g1[3] * hi_f(gsl.w));
          *(u32x4*)(Urow + 16 * lane + 8 * hlf) = wv; } }
}

#define XB_TMO      128
#define XB_XCNT(j)  (256  + 64 * (j))
#define XB_XSUB(j)  (1280 + 64 * (j))
#define XB_XGEN(j)  (2304 + 64 * (j))
#define XB_TOP      3328
#define XB_TOPGEN   3392
#define XCD_BAR_WORDS 3456
#define XB_SPIN_CAP (1u << 18)
DI unsigned xb_ld(unsigned* p)              { return __hip_atomic_load(p, __ATOMIC_RELAXED, __HIP_MEMORY_SCOPE_AGENT); }
DI unsigned xb_add(unsigned* p, unsigned v) { return __hip_atomic_fetch_add(p, v, __ATOMIC_RELAXED, __HIP_MEMORY_SCOPE_AGENT); }
DI unsigned xb_xcc_id() { return (unsigned)__builtin_amdgcn_s_getreg((3 << 11) | 20) & 0xFu; }
#define XB_SPIN(cond, bar) do { unsigned _sp = 0; while (cond) { __builtin_amdgcn_s_sleep(1); \
    if ((++_sp & 255u) == 0u) { if (xb_ld(&(bar)[XB_TMO])) break; if (_sp > XB_SPIN_CAP) { atomicAdd(&(bar)[XB_TMO], 1u); break; } } } } while (0)
struct XcdBarrier { unsigned* bar; unsigned x; volatile LAS unsigned* st; };
DI XcdBarrier xcd_barrier_post(unsigned* bar, volatile LAS unsigned* st) {
    XcdBarrier b; b.bar = bar; b.x = xb_xcc_id(); b.st = st;
    if (threadIdx.x == 0) (void)xb_add(&bar[XB_XCNT(b.x)], 1u);
    return b;
}
DI void xcd_barrier_complete(unsigned* bar, unsigned x, unsigned& nloc, unsigned& nx) {
    const unsigned G = gridDim.x * gridDim.y * gridDim.z;
    unsigned sum, cnt, mine, sp = 0u;
    for (;;) {
        sum = 0u; cnt = 0u; mine = 0u;
#pragma unroll
        for (unsigned j = 0; j < 16; ++j) { const unsigned c = xb_ld(&bar[XB_XCNT(j)]); sum += c; cnt += (c > 0u) ? 1u : 0u; mine = (j == x) ? c : mine; }
        if (sum == G) break;
        __builtin_amdgcn_s_sleep(1);
        if ((++sp & 255u) == 0u) { if (xb_ld(&bar[XB_TMO])) break; if (sp > XB_SPIN_CAP) { atomicAdd(&bar[XB_TMO], 1u); break; } }
    }
    nloc = mine > 0u ? mine : 1u; nx = cnt > 0u ? cnt : 1u;
}
DI void xcd_barrier(const XcdBarrier& b) {
    asm volatile("s_waitcnt vmcnt(0)" ::: "memory");
    __syncthreads();
    if (threadIdx.x == 0) {
        unsigned* bar = b.bar;
        __builtin_amdgcn_s_waitcnt(0);
        unsigned nloc = b.st[0], nx = b.st[1];
        if (nloc == 0u) { xcd_barrier_complete(bar, b.x, nloc, nx); b.st[0] = nloc; b.st[1] = nx; }
        const unsigned old = xb_add(&bar[XB_XSUB(b.x)], 1u);
        const unsigned gen = old / nloc;
        if (old + 1u == (gen + 1u) * nloc) {
            __builtin_amdgcn_fence(__ATOMIC_RELEASE, "agent");
            asm volatile("s_waitcnt vmcnt(0)" ::: "memory");
            const unsigned og = xb_add(&bar[XB_TOP], 1u);
            const unsigned tg = og / nx;
            if (og + 1u == (tg + 1u) * nx) xb_add(&bar[XB_TOPGEN], 1u);
            else XB_SPIN(xb_ld(&bar[XB_TOPGEN]) == tg, bar);
            __builtin_amdgcn_fence(__ATOMIC_ACQUIRE, "agent");
            xb_add(&bar[XB_XGEN(b.x)], 1u);
            asm volatile("s_waitcnt vmcnt(0)" ::: "memory");
        } else {
            XB_SPIN(xb_ld(&bar[XB_XGEN(b.x)]) == gen, bar);
            __builtin_amdgcn_fence(__ATOMIC_ACQUIRE, "agent");
            asm volatile("s_waitcnt vmcnt(0)" ::: "memory");
        }
    }
    __syncthreads();
}

struct Args { const float* in[20]; float* out; unsigned char* ws; int ph_lo, ph_hi; };
constexpr int NPB = 11;
constexpr int NPH = 1 + NBATCH * NPB;

__global__ void __launch_bounds__(512, 2) fwd_kernel(Args args) {
    extern __shared__ __attribute__((aligned(16))) unsigned char lds_raw[];
    LAS unsigned char* lds = (LAS unsigned char*)lds_raw;
    const int G = gridDim.x, bx = blockIdx.x;
    const int NGW = G * 8;
    const int wave = __builtin_amdgcn_readfirstlane((int)threadIdx.x >> 6), gw = bx * 8 + wave;
    unsigned char* ws = args.ws;
    const float* x_prompt = args.in[0]; const float* x_sample = args.in[1];
    bf16* W_in = (bf16*)(ws + WS_WIN); bf16* W_ho = (bf16*)(ws + WS_WHO); bf16* W_ao = (bf16*)(ws + WS_WAO); bf16* W_out = (bf16*)(ws + WS_WOUT);
    bf16* W_xq = (bf16*)(ws + WS_WXQ); bf16* W_xkv = (bf16*)(ws + WS_WXKV); bf16* W_xo = (bf16*)(ws + WS_WXO); bf16* W_f1 = (bf16*)(ws + WS_WF1); bf16* W_f2 = (bf16*)(ws + WS_WF2);
    float* LB = (float*)(ws + WS_LB); float* ROPE = (float*)(ws + WS_ROPE); float* SEGD = (float*)(ws + WS_SEGD); float* SEGL = (float*)(ws + WS_SEGL);
    bf16* MEMN = (bf16*)(ws + WS_MEMN); bf16* KMEM = (bf16*)(ws + WS_KMEM); bf16* VTMEM = (bf16*)(ws + WS_VTMEM); float* LSE = (float*)(ws + WS_LSE);
    bf16* U = (bf16*)(ws + WS_U); bf16* P = (bf16*)(ws + WS_P); float* SS = (float*)(ws + WS_SS);
    cg::grid_group grid = cg::this_grid();
    if (threadIdx.x < 2) *(volatile LAS unsigned*)(lds + LDS_BARST + 4 * threadIdx.x) = 0u;
    __syncthreads();
    XcdBarrier xbar = xcd_barrier_post((unsigned*)(ws + WS_CTL), (volatile LAS unsigned*)(lds + LDS_BARST));

    for (int ph = args.ph_lo; ph < args.ph_hi; ++ph) {
#define TID_INIT unsigned ones_ = ~0u; asm volatile("" : "+s"(ones_)); int tid = wave * 64 + (int)__builtin_amdgcn_mbcnt_hi(ones_, __builtin_amdgcn_mbcnt_lo(ones_, 0u)); asm volatile("" : "+v"(tid)); const int lane = tid & 63; (void)lane;
        if (ph == 0) {
            TID_INIT
            LAS float* scr = (LAS float*)(lds + wave * 16384);
            constexpr int I_IN = 16 * (NIN / 32), I_HO = 16 * 32, I_AO = 8 * 32, I_OUT = 16 * 32, I_XQ = 16 * 32, I_XKV = 16 * 64, I_XO = 16 * 32, I_F1 = 16 * 128, I_F2 = 64 * 32;
            constexpr int NITEMS = I_IN + I_HO + I_AO + I_OUT + I_XQ + I_XKV + I_XO + I_F1 + I_F2;
            for (int it = gw; it < NITEMS; it += NGW) {
                int r = it;
                if (r < I_IN) { p0_transpose_item(args.in[5], 1024, NIN, W_in, args.in[4], scr, r, lane); continue; } r -= I_IN;
                if (r < I_HO) { p0_transpose_item(args.in[8], 1024, 1024, W_ho, nullptr, scr, r, lane); continue; } r -= I_HO;
                if (r < I_AO) { p0_transpose_item(args.in[9], 512, 1024, W_ao, nullptr, scr, r, lane); continue; } r -= I_AO;
                if (r < I_OUT) { p0_transpose_item(args.in[10], 1024, 1024, W_out, nullptr, scr, r, lane); continue; } r -= I_OUT;
                if (r < I_XQ) { p0_transpose_item(args.in[13], 1024, 1024, W_xq, args.in[11], scr, r, lane); continue; } r -= I_XQ;
                if (r < I_XKV) { p0_transpose_item(args.in[14], 1024, 2048, W_xkv, args.in[12], scr, r, lane); continue; } r -= I_XKV;
                if (r < I_XO) { p0_transpose_item(args.in[15], 1024, 1024, W_xo, nullptr, scr, r, lane); continue; } r -= I_XO;
                if (r < I_F1) { p0_transpose_item(args.in[17], 1024, FF, W_f1, args.in[16], scr, r, lane); continue; } r -= I_F1;
                p0_transpose_item(args.in[18], FF, 1024, W_f2, nullptr, scr, r, lane);
            }
            const int gt = bx * 512 + tid, NGT = G * 512;
            for (int i = gt; i < 2048; i += NGT) { const int d = i >> 10, f = i & 1023; const float l0 = args.in[6][d * 2048 + f], l1 = args.in[6][d * 2048 + 1024 + f]; LB[i] = 1.0f / (1.0f + __expf(l1 - l0)); }
            for (int i = gt; i < SEQ * 16; i += NGT) {
                const int pos = i >> 4, fi = i & 15;
                const float invt[16] = {1.0f, 0.44036659598350525f, 0.1939227432012558f, 0.08539710193872452f, 0.03760603070259094f, 0.016560440883040428f, 0.007292664609849453f, 0.0032114461064338684f,
                                        0.0014142135623842478f, 0.0006227724370546639f, 0.00027424818836152554f, 0.00012076973507646471f, 5.3182957344688475e-05f, 2.34199997066753e-05f, 1.0313385246263351e-05f, 4.541670477919979e-06f};
                float inv = invt[0];
#pragma unroll
                for (int k = 1; k < 16; ++k) inv = (fi == k) ? invt[k] : inv;
                const float x = (float)pos * inv;
                const float kq = rintf(x * 0.63661977236758134308f);
                float r = fmaf(-kq, 1.5707855225e+00f, x); r = fmaf(-kq, 1.0804273188e-05f, r); r = fmaf(-kq, 6.0770999344e-11f, r);
                const float r2 = r * r;
                const float sn = r + r * r2 * (-1.0f / 6 + r2 * (1.0f / 120 + r2 * (-1.0f / 5040 + r2 * (1.0f / 362880))));
                const float cn = 1.0f + r2 * (-0.5f + r2 * (1.0f / 24 + r2 * (-1.0f / 720 + r2 * (1.0f / 40320 + r2 * (-1.0f / 3628800)))));
                const int qd = ((int)kq) & 3;
                const float c = (qd == 0) ? cn : (qd == 1) ? -sn : (qd == 2) ? -cn : sn;
                const float s = (qd == 0) ? sn : (qd == 1) ? cn : (qd == 2) ? -sn : -cn;
                ROPE[2 * i] = c; ROPE[2 * i + 1] = s;
            }
            for (int m = gw; m < NSEQ * NMEM; m += NGW) { const float* src = (m < 512) ? args.in[2] + (size_t)m * DM : args.in[3] + (size_t)(m - 512) * DM; norm_row_bf16(src, MEMN + (size_t)m * DM, lane); }
            for (int m = gw; m < BROWS; m += NGW) norm_row_bf16(x_prompt + (size_t)m * DM, U + (size_t)m * DM, lane);
        } else {
            const int b = (ph - 1) / NPB, pp = (ph - 1) % NPB + 1; const int j = (pp <= 6) ? pp : (pp == 7 ? 8 : (pp == 8 ? 10 : pp + 3)); const bool rep2 = false;
            const float* xb = (b == 0) ? x_prompt : x_sample + (size_t)(b - 1) * BROWS * DM;
            float* hb = args.out + (size_t)b * BROWS * DM;
            bf16* Of = (bf16*)hb; bf16* Ob = Of + (size_t)BROWS * DM;
            if (j == 1) {
                TID_INIT
                { pg8::Gemm g{U, W_in, BROWS, NIN, DM, DM}; pg8::StaticOrder S; S.init(BROWS, NIN, G, bx); pg8::EpiIn E{P, LB, ROPE};
                  pg8::gemm_phase<pg8::EpiIn, true>(lds, g, S, E, tid); }
                if (b == 0) { pg8::Gemm g{MEMN, W_xkv, NSEQ * NMEM, 2048, DM, DM}; pg8::StaticOrder S; S.init(NSEQ * NMEM, 2048, G, (bx + G / 2) % G); pg8::EpiKV E{KMEM, VTMEM};
                  pg8::gemm_phase<pg8::EpiKV, true>(lds, g, S, E, tid); }
            } else if (j == 2) {
                TID_INIT
                for (int it = bx; it < 256; it += G) hgrn_item<1>(lds, P, Of, Ob, SEGL, SEGD, it, tid);
                { const int vcu = (G % 8 == 0) ? (bx % 8) * (G / 8) + bx / 8 : bx;
                  dattn_items(lds, P, LSE, vcu, G, 1536, tid); }
            } else if (j == 3) {
                TID_INIT
                for (int it = bx; it < 256; it += G) hgrn_item<2>(lds, P, Of, Ob, SEGL, SEGD, it, tid);
            } else if (j == 4) {
                TID_INIT
                for (int m = gw; m < BROWS; m += NGW) post_row(P, m, Of + (size_t)m * DM, Ob + (size_t)m * DM, LSE + (size_t)m * 12, args.in[7], U + (size_t)m * DM, lane);
            } else if (j == 5) {
                TID_INIT
                { pg8::Gemm g{U, W_ho, BROWS, DM, DM, DM}; pg8::StaticOrder S; S.init(BROWS, DM, G, bx); pg8::EpiY<1> E{P}; pg8::gemm_phase<pg8::EpiY<1>, true>(lds, g, S, E, tid); }
                { pg8::Gemm g{P + OFF_ATT0, W_ao, BROWS, DM, 512, 512}; pg8::StaticOrder S; S.init(BROWS, DM, G, bx); pg8::EpiY<2> E{P}; pg8::gemm_phase<pg8::EpiY<2>, true>(lds, g, S, E, tid); }
            } else if (j == 6 || j == 10 || j == 13) {
                TID_INIT
                pg8::StaticOrder S; S.init(BROWS, DM, G, bx);
                if (j == 6) { pg8::Gemm g{P + OFF_GH, W_out, BROWS, DM, DM, 1024}; pg8::EpiRes<0> E{xb, nullptr, U, SS}; pg8::gemm_phase<pg8::EpiRes<0>, true>(lds, g, S, E, tid); }
                else if (j == 10) { pg8::Gemm g{P, W_xo, BROWS, DM, DM, DM}; pg8::EpiRes<1> E{nullptr, nullptr, U, SS + (size_t)BROWS * 16}; pg8::gemm_phase<pg8::EpiRes<1>, true>(lds, g, S, E, tid); }
                else { pg8::Gemm g{P, W_f2, BROWS, DM, FF, FF}; pg8::EpiRes<2> E{nullptr, hb, U, SS + (size_t)2 * BROWS * 16}; pg8::gemm_phase<pg8::EpiRes<2>, true>(lds, g, S, E, tid); }
            } else if (j == 7 || j == 11) {
                TID_INIT
                for (int m = gw; m < BROWS; m += NGW) norm_row_bf16(hb + (size_t)m * DM, U + (size_t)m * DM, lane);
            } else if (j == 8) {
                TID_INIT
                pg8::Gemm g{U, W_xq, BROWS, DM, DM, DM}; pg8::StaticOrder S; S.init(BROWS, DM, G, bx); pg8::EpiBf<0> E{P, DM, QSCALE_X, SS}; pg8::gemm_phase<pg8::EpiBf<0>, true>(lds, g, S, E, tid);
                asm volatile("s_waitcnt vmcnt(0)" ::: "memory"); __syncthreads();
                { pg8::Unit u0;
#pragma nounroll
                  for (int e = 0; S.next(e >> 1, u0); ++e)
                      xattn_item(lds, P, KMEM, VTMEM, b, ((u0.pm >> 5) * 4 + u0.pn) * 64 + 2 * (u0.pm & 31) + (e & 1), tid); }
            } else if (j == 12) {
                TID_INIT
                pg8::Gemm g{U, W_f1, BROWS, FF, DM, DM}; pg8::StaticOrder S; S.init(BROWS, FF, G, bx); pg8::EpiBf<1> E{P, FF, 1.0f, SS + (size_t)BROWS * 16}; pg8::gemm_phase<pg8::EpiBf<1>, true>(lds, g, S, E, tid);
            } else {
                TID_INIT
                for (int m = gw; m < BROWS; m += NGW) final_row_ss(hb + (size_t)m * DM, args.in[19], SS + ((size_t)2 * BROWS + m) * 16, lane);
                if (b + 1 < NBATCH) { const float* xn = x_sample + (size_t)b * BROWS * DM; for (int m = gw; m < BROWS; m += NGW) norm_row_bf16(xn + (size_t)m * DM, U + (size_t)m * DM, lane); }
            }
        }
        if (ph + 1 < args.ph_hi) {
            if (args.ph_lo < 0) { __threadfence(); grid.sync(); }
            xcd_barrier(xbar);
        }
        else __syncthreads();
    }
}

extern "C" void kernel_launch(void* const* d_in, const int* in_sizes, int n_in, void* d_out, int out_size, void* d_ws, size_t ws_size, hipStream_t stream) {
    static int grid = 0;
    if (grid == 0) {
        if (n_in != 20 || ws_size < WS_END) { fprintf(stderr, "kernel_launch: unexpected n_in %d / ws_size %zu\n", n_in, ws_size); grid = -1; return; }
        int dev = 0, cus = 0, per_cu = 0;
        hipGetDevice(&dev); hipDeviceGetAttribute(&cus, hipDeviceAttributeMultiprocessorCount, dev);
        if (hipFuncSetAttribute((const void*)fwd_kernel, hipFuncAttributeMaxDynamicSharedMemorySize, LDS_BYTES) != hipSuccess) { fprintf(stderr, "kernel_launch: hipFuncSetAttribute failed\n"); grid = -1; return; }
        hipOccupancyMaxActiveBlocksPerMultiprocessor(&per_cu, (const void*)fwd_kernel, 512, LDS_BYTES);
        (void)hipGetLastError();
        if (per_cu < 1) per_cu = 1;
        grid = cus;
        fprintf(stderr, "kernel_launch: cus %d per_cu %d grid %d\n", cus, per_cu, grid);
    }
    if (grid < 0) return;
    Args a{};
    for (int i = 0; i < 20; ++i) a.in[i] = (const float*)d_in[i];
    a.out = (float*)d_out; a.ws = (unsigned char*)d_ws;
#if ONE_LAUNCH
    if (hipMemsetAsync((char*)d_ws + WS_CTL, 0, CTL_BYTES, stream) != hipSuccess) { fprintf(stderr, "kernel_launch: memset failed\n"); return; }
    a.ph_lo = 0; a.ph_hi = NPH;
    void* kargs[] = {&a};
    hipError_t e = hipLaunchCooperativeKernel((const void*)fwd_kernel, dim3(grid), dim3(512), kargs, LDS_BYTES, stream);
    if (e != hipSuccess) fprintf(stderr, "cooperative launch failed: %s (grid %d)\n", hipGetErrorString(e), grid);
#else
    for (int ph = 0; ph < NPH; ++ph) {
        a.ph_lo = ph; a.ph_hi = ph + 1;
        hipLaunchKernelGGL(fwd_kernel, dim3(grid), dim3(512), LDS_BYTES, stream, a);
    }
#endif
}
```

```cpp
#include <hip/hip_runtime.h>
#include <hip/hip_cooperative_groups.h>
#include <cstdio>
#include <cstdint>
namespace cg = cooperative_groups;

#ifndef DBL
#define DBL 0
#endif
#ifndef ONE_LAUNCH
#define ONE_LAUNCH 1
#endif

#define DI __device__ __forceinline__
#define LAS __attribute__((address_space(3)))
typedef unsigned short bf16;
typedef short bf16x8 __attribute__((ext_vector_type(8)));
typedef short s16x4 __attribute__((ext_vector_type(4)));
typedef float f32x4 __attribute__((ext_vector_type(4)));
typedef float f32x2 __attribute__((ext_vector_type(2)));
typedef unsigned u32x4 __attribute__((ext_vector_type(4)));
typedef unsigned u32x2 __attribute__((ext_vector_type(2)));

constexpr int DM = 1024, SEQ = 8192, NSEQ = 6, TTOK = NSEQ * SEQ, BROWS = 2 * SEQ  , NBATCH = 3;
constexpr int NIN = 11776, FF = 4096, NMEM = 256;
constexpr int C_Q = 0, C_FF = 1024, C_FB = 2048, C_V = 3072, C_G = 4096, C_ATT = 5120, C_GH = 9728, C_GA = 10752;
constexpr size_t PE1 = (size_t)BROWS * 1024, PE2 = (size_t)BROWS * 512;
constexpr size_t OFF_Q = 0, OFF_FF = PE1, OFF_V = 3 * PE1, OFF_G = 4 * PE1, OFF_ATT0 = 5 * PE1, OFF_GH = 5 * PE1 + 9 * PE2, OFF_GA = OFF_GH + PE1;
constexpr float RMS_EPS = 1e-6f;
constexpr float QSCALE_A = 0.08838834764831845f * 1.4426950408889634f;
constexpr float QSCALE_X = 0.0625f * 1.4426950408889634f;

constexpr size_t MiB = 1u << 20;
constexpr int LDS_BYTES_ = 147456, LDS_BYTES = LDS_BYTES_;
constexpr size_t WS_WIN = 0, WS_WHO = 23 * MiB, WS_WAO = 25 * MiB, WS_WOUT = 26 * MiB, WS_WXQ = 28 * MiB, WS_WXKV = 30 * MiB, WS_WXO = 34 * MiB,
                 WS_WF1 = 36 * MiB, WS_WF2 = 44 * MiB;
constexpr size_t WS_LB = 52 * MiB, WS_ROPE = 52 * MiB + 65536, WS_SEGD = 53 * MiB + 524288, WS_MEMN = 54 * MiB, WS_KMEM = 57 * MiB, WS_VTMEM = 60 * MiB,
                 WS_LSE = 63 * MiB, WS_SEGL = 64 * MiB, WS_U = 80 * MiB, WS_P = 112 * MiB, WS_CTL = 480 * MiB, WS_END = 485 * MiB;
constexpr size_t CTL_BYTES = 16384;
constexpr size_t WS_SS = 481 * MiB;
constexpr int LDS_BARST = LDS_BYTES_ - 64;


DI float bf2f(unsigned short h) { return __uint_as_float((unsigned)h << 16); }
DI unsigned short f2bf(float f) { unsigned u = __float_as_uint(f); return (unsigned short)((u + 0x7fffu + ((u >> 16) & 1u)) >> 16); }
DI unsigned pk2(float lo, float hi) { return (unsigned)f2bf(lo) | ((unsigned)f2bf(hi) << 16); }
DI float lo_f(unsigned u) { return __uint_as_float(u << 16); }
DI float hi_f(unsigned u) { return __uint_as_float(u & 0xffff0000u); }
DI float sigmoidf_(float x) { return __builtin_amdgcn_rcpf(1.0f + __builtin_amdgcn_exp2f(x * -1.4426950408889634f)); }
DI unsigned cvtpk(float lo, float hi) { unsigned r; asm volatile("v_cvt_pk_bf16_f32 %0, %1, %2" : "=v"(r) : "v"(lo), "v"(hi)); return r; }
DI float ex2(float x) { return __builtin_amdgcn_exp2f(x); }
DI float wave_sum(float v) {
#pragma unroll
    for (int o = 1; o < 64; o <<= 1) v += __shfl_xor(v, o);
    return v;
}
#define MFMA16(a, b, c) __builtin_amdgcn_mfma_f32_16x16x32_bf16((a), (b), (c), 0, 0, 0)

namespace pg8 {
constexpr int BM = 256, BK = 64, HALF = 128, HTB = HALF * BK * 2, STAGE_BYTES = 8 * HTB, NXCD = 8, WGM = 2;
DI int lds_byte(int r, int c) { const int st = (r >> 4) * 2 + (c >> 5), rr = r & 15, cc = c & 31, ob = rr * 64 + cc * 2; return st * 1024 + (ob ^ (((ob >> 9) & 1) << 5)); }
DI void stage_rc(int b, int& R, int& C) { const int st = b / 1024, sb = b % 1024, swz = sb ^ (((sb >> 9) & 1) << 5); R = (st >> 1) * 16 + swz / 64; C = (st & 1) * 32 + (swz % 64) / 2; }
DI int perm32(int rho) { const int n = rho >> 4, i = rho & 15; return 8 * (i >> 2) + 4 * n + (i & 3); }
struct Unit { int pm, pn; };
struct Gemm { const bf16* A; const bf16* Bt; int M, N, K, lda; };
struct StaticOrder {
    int nM, nN, nwg, G, c, wgm;
    DI void init(int M, int N, int G_, int c_, int wgm_ = WGM) { nM = M / BM; nN = N / BM; nwg = nM * nN; G = G_; c = c_; wgm = wgm_; }
    DI bool next(int i, Unit& u) const {
        const long L = (long)i * G + c; if (L >= nwg) return false;
        int wgid = (int)L; { const int q = nwg / NXCD, r = nwg % NXCD, xcd = wgid % NXCD, off = wgid / NXCD; wgid = (xcd < r ? xcd * (q + 1) : r * (q + 1) + (xcd - r) * q) + off; }
        const int nig = wgm * nN, gid = wgid / nig, fm = gid * wgm, gsz = (nM - fm) < wgm ? (nM - fm) : wgm;
        u.pm = fm + ((wgid % nig) % gsz); u.pn = (wgid % nig) / gsz; return true;
    }
};
DI unsigned cvt_pk_bf16(float lo, float hi) { unsigned r; asm volatile("v_cvt_pk_bf16_f32 %0, %1, %2" : "=v"(r) : "v"(lo), "v"(hi)); return r; }

template <class Epi, bool ALIGN_EPI>
DI void gemm_phase(LAS unsigned char* lds, const Gemm g, const StaticOrder& S, const Epi& E, const int tid) {
    const int wid = __builtin_amdgcn_readfirstlane(tid >> 6), lane = tid & 63, wr = wid >> 2, wc = wid & 3, fr = lane & 15, fq = lane >> 4;
    const int K = g.K, nt = K / BK;
    unsigned voffA[2], voffB[2];
#pragma unroll
    for (int i = 0; i < 2; ++i) { int R, C; stage_rc(tid * 16 + i * 8192, R, C); const int Rb = Epi::PERM ? ((R & ~31) + perm32(R & 31)) : R;
        voffA[i] = (unsigned)(R * g.lda + C) * 2u; voffB[i] = (unsigned)(Rb * K + C) * 2u; }
    const size_t kstep = (size_t)(BK * 2);
    const size_t hstepA = (size_t)HALF * g.lda * 2, hstepB = (size_t)HALF * K * 2;
    const size_t tstepA = 2 * hstepA, tstepB = 2 * hstepB;
    const unsigned ldsw = (unsigned)wid * 1024u;
    const int aoff = lds_byte(wr * 64 + fr, fq * 8), boff = lds_byte(wc * 32 + fr, fq * 8);
#define PG8_SA(b, h) (((b) * 2 + (h)) * HTB)
#define PG8_SB(b, h) ((4 + (b) * 2 + (h)) * HTB)
#define PG8_STAGE(bufoff, gbase, voff) do { _Pragma("unroll") for (int _i = 0; _i < 2; ++_i) \
        __builtin_amdgcn_global_load_lds((const unsigned*)((const char*)(gbase) + (voff)[_i]), (LAS unsigned*)(lds + (bufoff) + ldsw + _i * 8192), 16, 0, 0); } while (0)
#define PG8_LDA(dst, b, h) do { _Pragma("unroll") for (int m = 0; m < 4; ++m) _Pragma("unroll") for (int k = 0; k < 2; ++k) dst[m][k] = *(const LAS bf16x8*)(lds + PG8_SA(b, h) + aoff + m * 2048 + k * 1024); } while (0)
#define PG8_LDB(dst, b, h) do { _Pragma("unroll") for (int n = 0; n < 2; ++n) _Pragma("unroll") for (int k = 0; k < 2; ++k) dst[n][k] = *(const LAS bf16x8*)(lds + PG8_SB(b, h) + boff + n * 2048 + k * 1024); } while (0)
#define PG8_MMA(ai, bj, At, Bt) do { __builtin_amdgcn_s_setprio(1); _Pragma("unroll") for (int m = 0; m < 4; ++m) _Pragma("unroll") for (int n = 0; n < 2; ++n) _Pragma("unroll") for (int k = 0; k < 2; ++k) \
        acc[ai][bj][m][n] = __builtin_amdgcn_mfma_f32_16x16x32_bf16(Bt[n][k], At[m][k], acc[ai][bj][m][n], 0, 0, 0); __builtin_amdgcn_s_setprio(0); } while (0)
#define PG8_WAIT_V(n) asm volatile("s_waitcnt vmcnt(" #n ")" ::: "memory")
#define PG8_WAIT_L(n) asm volatile("s_waitcnt lgkmcnt(" #n ")" ::: "memory")
#define PG8_BAR __builtin_amdgcn_s_barrier()
#define PG8_SCHED __builtin_amdgcn_sched_barrier(0)
    Unit cur, nxt; int ui = 0;
    if (!S.next(0, cur)) return;
    f32x4 acc[2][2][4][2];
#pragma unroll
    for (int a = 0; a < 2; ++a)
#pragma unroll
        for (int b = 0; b < 2; ++b)
#pragma unroll
            for (int m = 0; m < 4; ++m)
#pragma unroll
                for (int n = 0; n < 2; ++n) acc[a][b][m][n] = (f32x4){0.f, 0.f, 0.f, 0.f};
    bf16x8 At[4][2], B0[2][2], B1[2][2];
    const char* cA = (const char*)g.A + (size_t)cur.pm * tstepA; const char* cB = (const char*)g.Bt + (size_t)cur.pn * tstepB;
    PG8_STAGE(PG8_SB(0, 0), cB, voffB); PG8_STAGE(PG8_SB(0, 1), cB + hstepB, voffB); PG8_STAGE(PG8_SA(0, 0), cA, voffA); PG8_STAGE(PG8_SA(0, 1), cA + hstepA, voffA);
    if (wr == 1) PG8_BAR;
    PG8_WAIT_V(2); PG8_BAR;
    PG8_STAGE(PG8_SB(1, 0), cB + kstep, voffB); PG8_STAGE(PG8_SA(1, 0), cA + kstep, voffA); PG8_STAGE(PG8_SB(1, 1), cB + hstepB + kstep, voffB);
    PG8_WAIT_V(6); PG8_BAR;
    for (;;) {
        const bool has_next = S.next(ui + 1, nxt);
        const char* nA = has_next ? (const char*)g.A + (size_t)nxt.pm * tstepA : cA; const char* nB = has_next ? (const char*)g.Bt + (size_t)nxt.pn * tstepB : cB;
        for (int t = 0; t < nt; t += 2) {
            const bool last = (t == nt - 2);
            const char* a1 = cA + (size_t)(t + 1) * kstep;
            const char* a2 = last ? nA : cA + (size_t)(t + 2) * kstep; const char* b2 = last ? nB : cB + (size_t)(t + 2) * kstep;
            const char* a3 = a2 + kstep; const char* b3 = b2 + kstep;
            PG8_LDB(B0, 0, 0); PG8_LDB(B1, 0, 1); PG8_SCHED; PG8_LDA(At, 0, 0); PG8_STAGE(PG8_SA(1, 1), a1 + hstepA, voffA);
            PG8_WAIT_V(8); PG8_WAIT_L(0); PG8_BAR; PG8_MMA(0, 0, At, B0); PG8_MMA(0, 1, At, B1); PG8_BAR; PG8_SCHED;
            PG8_LDA(At, 0, 1); PG8_STAGE(PG8_SB(0, 0), b2, voffB); PG8_STAGE(PG8_SB(0, 1), b2 + hstepB, voffB); PG8_STAGE(PG8_SA(0, 0), a2, voffA);
            PG8_WAIT_V(8); PG8_WAIT_L(0); PG8_BAR; PG8_MMA(1, 0, At, B0); PG8_MMA(1, 1, At, B1); PG8_BAR; PG8_SCHED;
            PG8_LDB(B0, 1, 0); PG8_LDB(B1, 1, 1); PG8_SCHED; PG8_LDA(At, 1, 0); PG8_STAGE(PG8_SA(0, 1), a2 + hstepA, voffA);
            PG8_WAIT_V(8); PG8_WAIT_L(0); PG8_BAR; PG8_MMA(0, 0, At, B0); PG8_MMA(0, 1, At, B1); PG8_BAR; PG8_SCHED;
            PG8_LDA(At, 1, 1); PG8_STAGE(PG8_SB(1, 0), b3, voffB); PG8_STAGE(PG8_SB(1, 1), b3 + hstepB, voffB); PG8_STAGE(PG8_SA(1, 0), a3, voffA);
            PG8_WAIT_V(8); PG8_WAIT_L(0); PG8_BAR; PG8_MMA(1, 0, At, B0); PG8_MMA(1, 1, At, B1); PG8_BAR; PG8_SCHED;
        }
        if constexpr (ALIGN_EPI) { if (wr == 0) PG8_BAR; }
        E(acc, cur, wr, wc, fr, fq);
        if (!has_next) break;
#pragma unroll
        for (int a = 0; a < 2; ++a)
#pragma unroll
            for (int b = 0; b < 2; ++b)
#pragma unroll
                for (int m = 0; m < 4; ++m)
#pragma unroll
                    for (int n = 0; n < 2; ++n) acc[a][b][m][n] = (f32x4){0.f, 0.f, 0.f, 0.f};
        cur = nxt; cA = nA; cB = nB; ++ui;
        if constexpr (ALIGN_EPI) { if (wr == 1) PG8_BAR; }
    }
    PG8_WAIT_V(0);
    if constexpr (!ALIGN_EPI) { if (wr == 0) PG8_BAR; }
    PG8_BAR;
#undef PG8_SA
#undef PG8_SB
#undef PG8_STAGE
#undef PG8_LDA
#undef PG8_LDB
#undef PG8_MMA
#undef PG8_WAIT_V
#undef PG8_WAIT_L
#undef PG8_BAR
#undef PG8_SCHED
}

struct EpiIn {
    static constexpr bool PERM = true;
    bf16* P; const float* lb; const float* rope;
    DI void operator()(const f32x4 (&acc)[2][2][4][2], const Unit& u, int wr, int wc, int fr, int fq) const {
        const int seg = u.pn >> 1;
        int type, dir = 0;
        if (seg < 2) type = 0; else if (seg < 6) { type = 1; dir = (seg >= 4) ? 1 : 0; } else if (seg < 8) type = 2; else if (seg < 10) type = 0;
        else if (seg < 19) { const int t = (seg - 10) % 3; type = (t == 0) ? 4 : ((t == 1) ? 5 : 2); } else type = 3;
#pragma unroll
        for (int ai = 0; ai < 2; ++ai)
#pragma unroll
            for (int m = 0; m < 4; ++m) {
                const int row = u.pm * BM + ai * HALF + wr * 64 + m * 16 + fr;
                const int c0t = u.pn * BM;
                size_t toff; int pitch, lc;
                if (c0t < C_ATT) { toff = (size_t)(c0t >> 10) * PE1; pitch = 1024; lc = c0t & 1023; }
                else if (c0t < C_GH) { toff = OFF_ATT0 + (size_t)((c0t - C_ATT) >> 9) * PE2; pitch = 512; lc = (c0t - C_ATT) & 511; }
                else { toff = OFF_GH + (size_t)((c0t - C_GH) >> 10) * PE1; pitch = 1024; lc = (c0t - C_GH) & 1023; }
                bf16* rowp = P + toff + (size_t)row * pitch + lc;
#pragma unroll
                for (int bj = 0; bj < 2; ++bj) {
                    const int col0 = u.pn * BM + bj * HALF + wc * 32 + 8 * fq;
                    f32x4 v0 = acc[ai][bj][m][0], v1 = acc[ai][bj][m][1];
                    if (type == 0) {
#pragma unroll
                        for (int i = 0; i < 4; ++i) { v0[i] = v0[i] * sigmoidf_(v0[i]); v1[i] = v1[i] * sigmoidf_(v1[i]); }
                    } else if (type == 1) {
                        const float* lbp = lb + dir * 1024 + (col0 - (C_FF + 1024 * dir));
                        const f32x4 l0 = *(const f32x4*)lbp, l1 = *(const f32x4*)(lbp + 4);
#pragma unroll
                        for (int i = 0; i < 4; ++i) { v0[i] = __logf(l0[i] + (1.0f - l0[i]) * sigmoidf_(v0[i])); v1[i] = __logf(l1[i] + (1.0f - l1[i]) * sigmoidf_(v1[i])); }
                    } else if (type == 3) {
#pragma unroll
                        for (int i = 0; i < 4; ++i) { v0[i] = sigmoidf_(v0[i]); v1[i] = sigmoidf_(v1[i]); }
                    } else if (type == 4 || type == 5) {
                        if (wc == 0) {
                            const int pos = row & (SEQ - 1);
                            const float* rp = rope + ((size_t)pos * 16 + 8 * (fq & 1)) * 2;
                            const f32x4 ca = *(const f32x4*)rp, cb = *(const f32x4*)(rp + 4), cc = *(const f32x4*)(rp + 8), cd = *(const f32x4*)(rp + 12);
                            const float c[8] = {ca[0], ca[2], cb[0], cb[2], cc[0], cc[2], cd[0], cd[2]}, sn[8] = {ca[1], ca[3], cb[1], cb[3], cc[1], cc[3], cd[1], cd[3]};
                            const float sg = (fq < 2) ? -1.0f : 1.0f;
#pragma unroll
                            for (int i = 0; i < 4; ++i) {
                                const float p0 = __shfl_xor(v0[i], 32), p1 = __shfl_xor(v1[i], 32);
                                v0[i] = v0[i] * c[i] + sg * p0 * sn[i]; v1[i] = v1[i] * c[4 + i] + sg * p1 * sn[4 + i];
                            }
                        }
                        if (type == 4) { v0 = v0 * QSCALE_A; v1 = v1 * QSCALE_A; }
                    }
                    u32x4 w; w.x = cvt_pk_bf16(v0[0], v0[1]); w.y = cvt_pk_bf16(v0[2], v0[3]); w.z = cvt_pk_bf16(v1[0], v1[1]); w.w = cvt_pk_bf16(v1[2], v1[3]);
                    *(u32x4*)(rowp + bj * HALF + wc * 32 + 8 * fq) = w;
                }
            }
    }
};
struct EpiKV {
    static constexpr bool PERM = false;
    bf16* Km; bf16* Vt;
    DI void operator()(const f32x4 (&acc)[2][2][4][2], const Unit& u, int wr, int wc, int fr, int fq) const {
#pragma unroll
        for (int ai = 0; ai < 2; ++ai)
#pragma unroll
            for (int m = 0; m < 4; ++m) {
                const int row = u.pm * BM + ai * HALF + wr * 64 + m * 16 + fr;
#pragma unroll
                for (int bj = 0; bj < 2; ++bj)
#pragma unroll
                    for (int n = 0; n < 2; ++n) {
                        const int col0 = u.pn * BM + bj * HALF + wc * 32 + 16 * n + 4 * fq; const f32x4 v = acc[ai][bj][m][n];
                        if (col0 < 1024) { u32x2 w; w.x = cvt_pk_bf16(v[0], v[1]); w.y = cvt_pk_bf16(v[2], v[3]); *(u32x2*)(Km + (size_t)row * 1024 + col0) = w; }
                        else { const int cv = col0 - 1024, head = cv >> 8, d = cv & 255, sq = row >> 8, key = row & 255;
#pragma unroll
                            for (int i = 0; i < 4; ++i) Vt[((size_t)((sq * 4 + head) * 256 + d + i)) * 256 + key] = f2bf(v[i]); }
                    }
            }
    }
};
template <int WHICH> struct EpiY {
    static constexpr bool PERM = true;
    bf16* P;
    DI void operator()(const f32x4 (&acc)[2][2][4][2], const Unit& u, int wr, int wc, int fr, int fq) const {
#pragma unroll
        for (int ai = 0; ai < 2; ++ai)
#pragma unroll
            for (int m = 0; m < 4; ++m) {
                const int row = u.pm * BM + ai * HALF + wr * 64 + m * 16 + fr;
#pragma unroll
                for (int bj = 0; bj < 2; ++bj) {
                    const int col0 = u.pn * BM + bj * HALF + wc * 32 + 8 * fq;
                    bf16* gp = P + OFF_GH + (size_t)row * 1024 + col0;
                    const u32x4 gh = *(const u32x4*)gp;
                    const f32x4 a0 = acc[ai][bj][m][0], a1 = acc[ai][bj][m][1];
                    float o[8];
                    if (WHICH == 1) {
                        o[0] = lo_f(gh.x) * a0[0]; o[1] = hi_f(gh.x) * a0[1]; o[2] = lo_f(gh.y) * a0[2]; o[3] = hi_f(gh.y) * a0[3];
                        o[4] = lo_f(gh.z) * a1[0]; o[5] = hi_f(gh.z) * a1[1]; o[6] = lo_f(gh.w) * a1[2]; o[7] = hi_f(gh.w) * a1[3];
                    } else {
                        const u32x4 ga = *(const u32x4*)(gp + PE1);
                        o[0] = lo_f(gh.x) + lo_f(ga.x) * a0[0]; o[1] = hi_f(gh.x) + hi_f(ga.x) * a0[1]; o[2] = lo_f(gh.y) + lo_f(ga.y) * a0[2]; o[3] = hi_f(gh.y) + hi_f(ga.y) * a0[3];
                        o[4] = lo_f(gh.z) + lo_f(ga.z) * a1[0]; o[5] = hi_f(gh.z) + hi_f(ga.z) * a1[1]; o[6] = lo_f(gh.w) + lo_f(ga.w) * a1[2]; o[7] = hi_f(gh.w) + hi_f(ga.w) * a1[3];
                    }
                    u32x4 w; w.x = cvt_pk_bf16(o[0], o[1]); w.y = cvt_pk_bf16(o[2], o[3]); w.z = cvt_pk_bf16(o[4], o[5]); w.w = cvt_pk_bf16(o[6], o[7]);
                    *(u32x4*)gp = w;
                }
            }
    }
};
template <int MODE> struct EpiRes {
    static constexpr bool PERM = true;
    const float* xin; float* out; bf16* hb16; float* ss;
    DI void operator()(const f32x4 (&acc)[2][2][4][2], const Unit& u, int wr, int wc, int fr, int fq) const {
#pragma unroll
        for (int ai = 0; ai < 2; ++ai)
#pragma unroll
            for (int m = 0; m < 4; ++m) {
                const int row = u.pm * BM + ai * HALF + wr * 64 + m * 16 + fr;
                const size_t off = (size_t)row * DM + u.pn * BM + wc * 32 + 8 * fq;
                float part = 0.f;
#pragma unroll
                for (int bj = 0; bj < 2; ++bj) {
                    f32x4 v0, v1;
                    if (MODE == 0) { v0 = *(const f32x4*)(xin + off + bj * HALF); v1 = *(const f32x4*)(xin + off + bj * HALF + 4); }
                    else { const u32x4 hb = *(const u32x4*)(hb16 + off + bj * HALF); v0 = (f32x4){lo_f(hb.x), hi_f(hb.x), lo_f(hb.y), hi_f(hb.y)}; v1 = (f32x4){lo_f(hb.z), hi_f(hb.z), lo_f(hb.w), hi_f(hb.w)}; }
                    v0 = v0 + acc[ai][bj][m][0]; v1 = v1 + acc[ai][bj][m][1];
                    if (MODE == 2) { *(f32x4*)(out + off + bj * HALF) = v0; *(f32x4*)(out + off + bj * HALF + 4) = v1; }
                    else { u32x4 w; w.x = cvt_pk_bf16(v0[0], v0[1]); w.y = cvt_pk_bf16(v0[2], v0[3]); w.z = cvt_pk_bf16(v1[0], v1[1]); w.w = cvt_pk_bf16(v1[2], v1[3]); *(u32x4*)(hb16 + off + bj * HALF) = w;
                        v0 = (f32x4){lo_f(w.x), hi_f(w.x), lo_f(w.y), hi_f(w.y)}; v1 = (f32x4){lo_f(w.z), hi_f(w.z), lo_f(w.w), hi_f(w.w)}; }
                    part += (v0[0] * v0[0] + v0[1] * v0[1]) + (v0[2] * v0[2] + v0[3] * v0[3]) + (v1[0] * v1[0] + v1[1] * v1[1]) + (v1[2] * v1[2] + v1[3] * v1[3]);
                }
                part += __shfl_xor(part, 16); part += __shfl_xor(part, 32); if (fq == 0) ss[(size_t)row * 16 + u.pn * 4 + wc] = part;
            }
    }
};
template <int ACT> struct EpiBf {
    static constexpr bool PERM = true;
    bf16* O; int ldc; float scale; const float* ss;
    DI void operator()(const f32x4 (&acc)[2][2][4][2], const Unit& u, int wr, int wc, int fr, int fq) const {
#pragma unroll
        for (int ai = 0; ai < 2; ++ai)
#pragma unroll
            for (int m = 0; m < 4; ++m) {
                const int row = u.pm * BM + ai * HALF + wr * 64 + m * 16 + fr;
                bf16* rowp = O + (size_t)row * ldc + u.pn * BM + wc * 32 + 8 * fq;
                float ssum; { const f32x4* sp = (const f32x4*)(ss + (size_t)row * 16); const f32x4 s0 = sp[0], s1 = sp[1], s2 = sp[2], s3 = sp[3];
                    ssum = ((s0[0] + s0[1]) + (s0[2] + s0[3])) + ((s1[0] + s1[1]) + (s1[2] + s1[3])) + ((s2[0] + s2[1]) + (s2[2] + s2[3])) + ((s3[0] + s3[1]) + (s3[2] + s3[3])); }
                const float rstd = rsqrtf(ssum * (1.0f / DM) + RMS_EPS);
                const float sc = (ACT == 1) ? rstd * rstd : rstd * scale;
#pragma unroll
                for (int bj = 0; bj < 2; ++bj) {
                    f32x4 v0 = acc[ai][bj][m][0], v1 = acc[ai][bj][m][1];
                    if (ACT == 1) {
#pragma unroll
                        for (int i = 0; i < 4; ++i) { const float a = fmaxf(v0[i], 0.f), b = fmaxf(v1[i], 0.f); v0[i] = a * a * sc; v1[i] = b * b * sc; }
                    } else { v0 = v0 * sc; v1 = v1 * sc; }
                    u32x4 w; w.x = cvt_pk_bf16(v0[0], v0[1]); w.y = cvt_pk_bf16(v0[2], v0[3]); w.z = cvt_pk_bf16(v1[0], v1[1]); w.w = cvt_pk_bf16(v1[2], v1[3]);
                    *(u32x4*)(rowp + bj * HALF) = w;
                }
            }
    }
};
}

DI void p0_transpose_item(const float* W, int K, int N, bf16* WT, const float* gain, LAS float* scr, int item, int lane) {
    const int nblk = N / 32, kb = item / nblk, nb = item % nblk, k0 = 64 * kb, n0 = 32 * nb;
    float wv[32];
#pragma unroll
    for (int i = 0; i < 32; ++i) { const int kk = 2 * i + (lane >> 5); wv[i] = W[(size_t)(k0 + kk) * N + n0 + (lane & 31)]; }
    if (gain) {
#pragma unroll
        for (int i = 0; i < 32; ++i) wv[i] *= gain[k0 + 2 * i + (lane >> 5)];
    }
#pragma unroll
    for (int i = 0; i < 32; ++i) { const int kk = 2 * i + (lane >> 5); scr[kk * 33 + (lane & 31)] = wv[i]; }
    asm volatile("s_waitcnt lgkmcnt(0)" ::: "memory");
    const int c = lane & 7;
#pragma unroll
    for (int j = 0; j < 4; ++j) { const int n = (lane >> 3) + 8 * j; const LAS float* s = scr + (8 * c) * 33 + n;
        u32x4 o; o.x = pk2(s[0 * 33], s[1 * 33]); o.y = pk2(s[2 * 33], s[3 * 33]); o.z = pk2(s[4 * 33], s[5 * 33]); o.w = pk2(s[6 * 33], s[7 * 33]);
        *(u32x4*)(WT + (size_t)(n0 + n) * K + k0 + 8 * c) = o; }
    asm volatile("s_waitcnt lgkmcnt(0)" ::: "memory");
}
DI void norm_row_bf16(const float* xrow, bf16* orow, int lane) {
    const f32x4* xr = (const f32x4*)xrow + lane;
    f32x4 v[4]; float s = 0.f;
#pragma unroll
    for (int j = 0; j < 4; ++j) { v[j] = xr[64 * j]; s += (v[j].x * v[j].x + v[j].y * v[j].y) + (v[j].z * v[j].z + v[j].w * v[j].w); }
    const float rstd = rsqrtf(wave_sum(s) * (1.f / DM) + RMS_EPS);
    u32x2* o8 = (u32x2*)orow + lane;
#pragma unroll
    for (int j = 0; j < 4; ++j) { u32x2 w; w.x = pk2(v[j].x * rstd, v[j].y * rstd); w.y = pk2(v[j].z * rstd, v[j].w * rstd); o8[64 * j] = w; }
}
DI void final_row_ss(float* hrow, const float* g, const float* ssp, int lane) {
    f32x4* xr = (f32x4*)hrow + lane; const f32x4* gr = (const f32x4*)g + lane;
    const f32x4 s0 = ((const f32x4*)ssp)[0], s1 = ((const f32x4*)ssp)[1], s2 = ((const f32x4*)ssp)[2], s3 = ((const f32x4*)ssp)[3];
    const float ssrow = ((s0[0] + s0[1]) + (s0[2] + s0[3])) + ((s1[0] + s1[1]) + (s1[2] + s1[3])) + ((s2[0] + s2[1]) + (s2[2] + s2[3])) + ((s3[0] + s3[1]) + (s3[2] + s3[3]));
    const float rstd = rsqrtf(ssrow * (1.f / DM) + RMS_EPS);
    f32x4 v[4];
#pragma unroll
    for (int j = 0; j < 4; ++j) v[j] = xr[64 * j];
#pragma unroll
    for (int j = 0; j < 4; ++j) xr[64 * j] = v[j] * rstd * gr[64 * j];
}
DI void final_row(float* hrow, const float* g, int lane) {
    f32x4* xr = (f32x4*)hrow + lane; const f32x4* gr = (const f32x4*)g + lane;
    f32x4 v[4]; float s = 0.f;
#pragma unroll
    for (int j = 0; j < 4; ++j) { v[j] = xr[64 * j]; s += (v[j].x * v[j].x + v[j].y * v[j].y) + (v[j].z * v[j].z + v[j].w * v[j].w); }
    const float rstd = rsqrtf(wave_sum(s) * (1.f / DM) + RMS_EPS);
#pragma unroll
    for (int j = 0; j < 4; ++j) xr[64 * j] = v[j] * rstd * gr[64 * j];
}

constexpr int HG_QD = 0, HG_KD = 17408, HG_QS = 34816, HG_K0E = 52224, HG_KST = 60928, HG_VT = 79360, HG_AM = 97792, HG_TOT = 107008, HG_DL = 109056;
template <int PASS>
DI void hgrn_item(LAS unsigned char* lds, const bf16* Pb, bf16* Of, bf16* Ob, float* segL, float* segD, int item, int tid) {
    const int lane = tid & 63, w = __builtin_amdgcn_readfirstlane(tid >> 6), r16 = lane & 15, q4 = lane >> 4;
    const int sg = item & 7, dir = (item >> 3) & 1, head = (item >> 4) & 7, sq = item >> 7;
    if (PASS == 1 && sg == 7) return;
    const int kcol = tid & 127, qtr = tid >> 7;
    const char* ubq = (const char*)(Pb + OFF_Q + (size_t)sq * SEQ * 1024 + head * 128);
    const char* ubf = (const char*)(Pb + OFF_FF + (size_t)dir * PE1 + (size_t)sq * SEQ * 1024 + head * 128);
    const char* ubv = (const char*)(Pb + OFF_V + (size_t)sq * SEQ * 1024 + head * 128);
    const unsigned voff0 = (unsigned)kcol * 2u + (unsigned)(dir ? 63 - 16 * qtr : 16 * qtr) * 2048u;
    const int vstep = dir ? -2048 : 2048;
    bf16* Od = (dir ? Ob : Of) + (size_t)sq * SEQ * DM + head * 128 + 16 * w + r16;
    f32x4 S[8];
#pragma unroll
    for (int kt = 0; kt < 8; ++kt) S[kt] = (f32x4){0.f, 0.f, 0.f, 0.f};
    if (PASS == 2) {
        for (int s2 = 0; s2 < sg; ++s2) {
            const int it2 = item - sg + s2;
            const float* Lp = segL + (size_t)it2 * 16384 + (size_t)(w * 8) * 256 + lane;
            const float* Dp = segD + (size_t)it2 * 128 + 4 * q4;
#pragma unroll
            for (int kt = 0; kt < 8; ++kt) { const f32x4 d = *(const f32x4*)(Dp + 16 * kt);
#pragma unroll
                for (int i = 0; i < 4; ++i) S[kt][i] = d[i] * S[kt][i] + Lp[(kt * 4 + i) * 64]; }
        }
    }
    float bseg = 0.f;
    LAS float* TOT = (LAS float*)(lds + HG_TOT); LAS float* DL = (LAS float*)(lds + HG_DL);
    unsigned short qv[16], vv[16], lfn[16];
#define HG_LOAD(pp) do { const size_t cb_ = (size_t)(dir ? (SEQ - 64 * ((pp) + 1)) : (64 * (pp))) * 2048;     \
        const char* cq_ = ubq + cb_; const char* cf_ = ubf + cb_; const char* cv_ = ubv + cb_; \
        _Pragma("unroll") for (int i = 0; i < 16; ++i) { const unsigned vo_ = voff0 + (unsigned)(vstep * i); \
            lfn[i] = *(const bf16*)(cf_ + vo_); vv[i] = *(const bf16*)(cv_ + vo_); if (PASS == 2) qv[i] = *(const bf16*)(cq_ + vo_); } } while (0)
    HG_LOAD(sg * 16);
    for (int j = 0; j < 16; ++j) {
        const int p = sg * 16 + j;
        float cs[16]; unsigned short lfr[16];
#pragma unroll
        for (int i = 0; i < 16; ++i) lfr[i] = lfn[i];
        { float run = 0.f;
#pragma unroll
          for (int i = 0; i < 16; ++i) { run += bf2f(lfr[i]); cs[i] = run; } }
        TOT[qtr * 128 + kcol] = cs[15];
        { u32x4 a, b; a.x = vv[0] | ((unsigned)vv[1] << 16); a.y = vv[2] | ((unsigned)vv[3] << 16); a.z = vv[4] | ((unsigned)vv[5] << 16); a.w = vv[6] | ((unsigned)vv[7] << 16);
          b.x = vv[8] | ((unsigned)vv[9] << 16); b.y = vv[10] | ((unsigned)vv[11] << 16); b.z = vv[12] | ((unsigned)vv[13] << 16); b.w = vv[14] | ((unsigned)vv[15] << 16);
          LAS u32x4* vp = (LAS u32x4*)(lds + HG_VT + kcol * 144 + qtr * 32); vp[0] = a; vp[1] = b; }
        __syncthreads();
        const float t0 = TOT[kcol], t1 = TOT[128 + kcol], t2 = TOT[256 + kcol], t3 = TOT[384 + kcol];
        const float off = (qtr > 0 ? t0 : 0.f) + (qtr > 1 ? t1 : 0.f) + (qtr > 2 ? t2 : 0.f);
        const float r1 = t0 + t1, blast = (t0 + t1) + (t2 + t3);
        const float rblk = (qtr >= 2) ? r1 : 0.f;
        if (qtr == 0) { DL[kcol] = ex2(blast * 1.4426950408889634f); bseg += blast; }
        unsigned ks[8];
        constexpr float L2E = 1.4426950408889634f;
        const float er1 = ex2(r1 * L2E), ebl1 = ex2((blast - r1) * L2E);
#pragma unroll
        for (int i = 0; i < 16; i += 2) {
            float kk[2], bb[2], e1[2], e2[2], eks[2], e3[2];
#pragma unroll
            for (int e = 0; e < 2; ++e) {
                bb[e] = off + cs[i + e]; kk[e] = 1.0f - ex2(bf2f(lfr[i + e]) * L2E);
                if (qtr < 2) {
                    e1[e] = ex2(bb[e] * L2E); e2[e] = ex2(fminf(-bb[e], 80.f) * L2E); e3[e] = ex2((r1 - bb[e]) * L2E); eks[e] = e3[e] * ebl1;
                } else {
                    e1[e] = ex2((bb[e] - r1) * L2E); e2[e] = ex2(fminf(r1 - bb[e], 80.f) * L2E); e3[e] = 0.f; eks[e] = ex2((blast - bb[e]) * L2E);
                }
            }
            ks[i >> 1] = cvtpk(kk[0] * eks[0], kk[1] * eks[1]);
            if (PASS == 2) {
                const float q0 = bf2f(qv[i]), q1 = bf2f(qv[i + 1]);
                const int tau = 16 * qtr + i;
                const unsigned wqd = cvtpk(q0 * e1[0], q1 * e1[1]);
                const unsigned wkd = cvtpk(kk[0] * e2[0], kk[1] * e2[1]);
                const unsigned wqs = (qtr < 2) ? wqd : cvtpk(q0 * e1[0] * er1, q1 * e1[1] * er1);
                *(LAS bf16*)(lds + HG_QD + tau * 272 + kcol * 2) = (bf16)(wqd & 0xffffu); *(LAS bf16*)(lds + HG_QD + (tau + 1) * 272 + kcol * 2) = (bf16)(wqd >> 16);
                *(LAS bf16*)(lds + HG_KD + tau * 272 + kcol * 2) = (bf16)(wkd & 0xffffu); *(LAS bf16*)(lds + HG_KD + (tau + 1) * 272 + kcol * 2) = (bf16)(wkd >> 16);
                *(LAS bf16*)(lds + HG_QS + tau * 272 + kcol * 2) = (bf16)(wqs & 0xffffu); *(LAS bf16*)(lds + HG_QS + (tau + 1) * 272 + kcol * 2) = (bf16)(wqs >> 16);
                if (qtr < 2) { const unsigned wk0 = cvtpk(kk[0] * e3[0], kk[1] * e3[1]);
                    *(LAS bf16*)(lds + HG_K0E + tau * 272 + kcol * 2) = (bf16)(wk0 & 0xffffu); *(LAS bf16*)(lds + HG_K0E + (tau + 1) * 272 + kcol * 2) = (bf16)(wk0 >> 16); }
            }
        }
        { LAS u32x4* kp = (LAS u32x4*)(lds + HG_KST + kcol * 144 + qtr * 32); kp[0] = (u32x4){ks[0], ks[1], ks[2], ks[3]}; kp[1] = (u32x4){ks[4], ks[5], ks[6], ks[7]}; }
        __syncthreads();
        if (j + 1 < 16) HG_LOAD(p + 1);
        if (PASS == 2) {
            const int ti = w >> 1;
#pragma unroll
            for (int e = 0; e < 2; ++e) {
                const int sj = 2 * (w & 1) + e;
                f32x4 a4 = (f32x4){0.f, 0.f, 0.f, 0.f};
                if (sj <= ti) {
                    const int bsrc = (ti >= 2 && sj < 2) ? HG_K0E : HG_KD;
                    bf16x8 fa[4], fb[4];
#pragma unroll
                    for (int st = 0; st < 4; ++st) {
                        fa[st] = *(const LAS bf16x8*)(lds + HG_QD + (16 * ti + r16) * 272 + (32 * st + 8 * q4) * 2);
                        fb[st] = *(const LAS bf16x8*)(lds + bsrc + (16 * sj + r16) * 272 + (32 * st + 8 * q4) * 2);
                    }
                    __builtin_amdgcn_sched_barrier(0);
#pragma unroll
                    for (int st = 0; st < 4; ++st) a4 = MFMA16(fa[st], fb[st], a4);
                    __builtin_amdgcn_sched_barrier(0);
                }
#pragma unroll
                for (int i = 0; i < 4; ++i) { const int t = 16 * ti + 4 * q4 + i, s = 16 * sj + r16; *(LAS bf16*)(lds + HG_AM + t * 144 + s * 2) = f2bf(s <= t ? a4[i] : 0.f); }
            }
            __syncthreads();
        }
        bf16x8 bv[2];
#pragma unroll
        for (int st = 0; st < 2; ++st) bv[st] = *(const LAS bf16x8*)(lds + HG_VT + (16 * w + r16) * 144 + (32 * st + 8 * q4) * 2);
        if (PASS == 2) {
            bf16x8 sb[4];
#pragma unroll
            for (int k2 = 0; k2 < 4; ++k2) { u32x4 pz; pz.x = pk2(S[2 * k2][0], S[2 * k2][1]); pz.y = pk2(S[2 * k2][2], S[2 * k2][3]); pz.z = pk2(S[2 * k2 + 1][0], S[2 * k2 + 1][1]); pz.w = pk2(S[2 * k2 + 1][2], S[2 * k2 + 1][3]);
                sb[k2] = __builtin_bit_cast(bf16x8, pz); }
#pragma unroll
            for (int ti = 0; ti < 4; ++ti) {
                f32x4 o4 = (f32x4){0.f, 0.f, 0.f, 0.f};
                bf16x8 fam[2]; s16x4 ql[4], qh[4];
#pragma unroll
                for (int st = 0; st < 2; ++st) fam[st] = *(const LAS bf16x8*)(lds + HG_AM + (16 * ti + r16) * 144 + (32 * st + 8 * q4) * 2);
#pragma unroll
                for (int k2 = 0; k2 < 4; ++k2) {
                    ql[k2] = *(const LAS s16x4*)(lds + HG_QS + (16 * ti + r16) * 272 + (32 * k2 + 4 * q4) * 2);
                    qh[k2] = *(const LAS s16x4*)(lds + HG_QS + (16 * ti + r16) * 272 + (32 * k2 + 16 + 4 * q4) * 2);
                }
                __builtin_amdgcn_sched_barrier(0);
#pragma unroll
                for (int st = 0; st < 2; ++st) o4 = MFMA16(fam[st], bv[st], o4);
#pragma unroll
                for (int k2 = 0; k2 < 4; ++k2) o4 = MFMA16(__builtin_shufflevector(ql[k2], qh[k2], 0, 1, 2, 3, 4, 5, 6, 7), sb[k2], o4);
                __builtin_amdgcn_sched_barrier(0);
#pragma unroll
                for (int i = 0; i < 4; ++i) { const int tau = 16 * ti + 4 * q4 + i; const int tok = dir ? (SEQ - 1 - 64 * p - tau) : (64 * p + tau); Od[(size_t)tok * DM] = f2bf(o4[i]); }
            }
        }
#pragma unroll
        for (int kh = 0; kh < 2; ++kh) {
            bf16x8 fk[4][2]; f32x4 dd[4];
#pragma unroll
            for (int k4 = 0; k4 < 4; ++k4) { const int kt = 4 * kh + k4;
                dd[k4] = *(const LAS f32x4*)(lds + HG_DL + (16 * kt + 4 * q4) * 4);
#pragma unroll
                for (int st = 0; st < 2; ++st) fk[k4][st] = *(const LAS bf16x8*)(lds + HG_KST + (16 * kt + r16) * 144 + (32 * st + 8 * q4) * 2); }
            __builtin_amdgcn_sched_barrier(0);
#pragma unroll
            for (int k4 = 0; k4 < 4; ++k4) { const int kt = 4 * kh + k4; S[kt] = S[kt] * dd[k4]; }
#pragma unroll
            for (int st = 0; st < 2; ++st)
#pragma unroll
                for (int k4 = 0; k4 < 4; ++k4) { const int kt = 4 * kh + k4; S[kt] = MFMA16(fk[k4][st], bv[st], S[kt]); }
            __builtin_amdgcn_sched_barrier(0);
        }
        __syncthreads();
    }
    if (PASS == 1) {
        float* Lp = segL + (size_t)item * 16384 + (size_t)(w * 8) * 256 + lane;
#pragma unroll
        for (int kt = 0; kt < 8; ++kt)
#pragma unroll
            for (int i = 0; i < 4; ++i) Lp[(kt * 4 + i) * 64] = S[kt][i];
        if (qtr == 0) segD[(size_t)item * 128 + kcol] = __expf(bseg);
    }
}

constexpr int DA_K = 0, DA_V = 69632;
typedef short v4i16_t __attribute__((ext_vector_type(4)));
DI s16x4 vtr(LAS unsigned char* p) { return __builtin_bit_cast(s16x4, __builtin_amdgcn_ds_read_tr16_b64_v4i16((LAS v4i16_t*)p)); }
struct DaIdx { int head, g, sq, dil, L, res, m0, qcol; };
DI DaIdx da_index(int item) {
    DaIdx d; const int idx = item & 63; d.head = (item >> 6) & 3; d.g = (item >> 8) % 3; d.sq = (item >> 8) / 3;
    d.dil = (d.g == 0) ? 1 : ((d.g == 1) ? 4 : 16); d.L = SEQ / d.dil; const int tpr = d.L / 128; d.res = idx / tpr; d.m0 = 128 * (idx % tpr);
    d.qcol = 128 * d.head; return d;
}
DI void da_load(const bf16* Pb, int item, int tid, u32x4 (&kreg)[8], u32x4 (&vreg)[8], bf16x8 (&qf)[4]) {
    const DaIdx d = da_index(item);
    const int lane = tid & 63, w = tid >> 6, r16 = lane & 15, q4 = lane >> 4;
    const bf16* rowbase = Pb + OFF_ATT0 + (size_t)(3 * d.g) * PE2 + (size_t)d.sq * SEQ * 512;
    const bf16* qrow = rowbase + (size_t)((d.m0 + 16 * w + r16) * d.dil + d.res) * 512 + d.qcol;
#pragma unroll
    for (int st = 0; st < 4; ++st) qf[st] = *(const bf16x8*)(qrow + 32 * st + 8 * q4);
#pragma unroll
    for (int it = 0; it < 8; ++it) {
        const int e = it * 512 + tid, key = e >> 4, ch = e & 15, m = d.m0 - 64 + key;
        kreg[it] = (u32x4){0u, 0u, 0u, 0u}; vreg[it] = kreg[it];
        if (m >= 0 && m < d.L) { const bf16* rp = rowbase + (size_t)(m * d.dil + d.res) * 512 + d.qcol + ch * 8; kreg[it] = *(const u32x4*)(rp + PE2); vreg[it] = *(const u32x4*)(rp + 2 * PE2); }
    }
}
DI void dattn_items(LAS unsigned char* lds, bf16* Pb, float* lse, int first, int stride, int nitems, int tid) {
    const int lane = tid & 63, w = __builtin_amdgcn_readfirstlane(tid >> 6), r16 = lane & 15, q4 = lane >> 4;
    u32x4 kreg[8], vreg[8]; bf16x8 qn[4];
    if (first < nitems) da_load(Pb, first, tid, kreg, vreg, qn);
    for (int item = first; item < nitems; item += stride) {
    const DaIdx d = da_index(item);
    const int head = d.head, g = d.g, sq = d.sq, dil = d.dil, L = d.L, res = d.res, m0 = d.m0, qcol = d.qcol;
    bf16* rowbase = Pb + OFF_ATT0 + (size_t)(3 * g) * PE2 + (size_t)sq * SEQ * 512;
    const int mq = m0 + 16 * w + r16;
    bf16* qrow = rowbase + (size_t)(mq * dil + res) * 512 + qcol;
    bf16x8 qf[4];
#pragma unroll
    for (int st = 0; st < 4; ++st) qf[st] = qn[st];
#pragma unroll
    for (int it = 0; it < 8; ++it) {
        const int e = it * 512 + tid, key = e >> 4, ch = e & 15;
        *(LAS u32x4*)(lds + DA_K + key * 272 + ch * 16) = kreg[it];
        *(LAS u32x4*)(lds + DA_V + key * 288 + ch * 16) = vreg[it];
    }
    __syncthreads();
    if (item + stride < nitems) da_load(Pb, item + stride, tid, kreg, vreg, qn);
    f32x4 sc[9];
    float mx = -1e30f;
#pragma unroll
    for (int kt = 0; kt < 9; ++kt) {
        f32x4 a4 = (f32x4){0.f, 0.f, 0.f, 0.f};
        bf16x8 fa[4];
#pragma unroll
        for (int st = 0; st < 4; ++st) fa[st] = *(const LAS bf16x8*)(lds + DA_K + (16 * w + 16 * kt + r16) * 272 + (32 * st + 8 * q4) * 2);
        __builtin_amdgcn_sched_barrier(0);
#pragma unroll
        for (int st = 0; st < 4; ++st) a4 = MFMA16(fa[st], qf[st], a4);
        __builtin_amdgcn_sched_barrier(0);
#pragma unroll
        for (int i = 0; i < 4; ++i) { const int mk = m0 - 64 + 16 * w + 16 * kt + 4 * q4 + i; const int dd = mk - mq;
            const bool ok = (mk >= 0) && (mk < L) && (dd <= 64) && (dd >= -64); a4[i] = ok ? a4[i] : -1e30f; mx = fmaxf(mx, a4[i]); }
        sc[kt] = a4;
    }
    mx = fmaxf(mx, __shfl_xor(mx, 16)); mx = fmaxf(mx, __shfl_xor(mx, 32));
    float sum = 0.f;
#pragma unroll
    for (int kt = 0; kt < 9; ++kt)
#pragma unroll
        for (int i = 0; i < 4; ++i) { const float pv = __builtin_amdgcn_exp2f(sc[kt][i] - mx); sc[kt][i] = pv; sum += pv; }
    sum += __shfl_xor(sum, 16); sum += __shfl_xor(sum, 32);
    bf16x8 pb[5];
#pragma unroll
    for (int pp = 0; pp < 5; ++pp) { u32x4 pz; pz.x = pk2(sc[2 * pp][0], sc[2 * pp][1]); pz.y = pk2(sc[2 * pp][2], sc[2 * pp][3]);
        if (pp < 4) { pz.z = pk2(sc[2 * pp + 1][0], sc[2 * pp + 1][1]); pz.w = pk2(sc[2 * pp + 1][2], sc[2 * pp + 1][3]); } else { pz.z = 0u; pz.w = 0u; }
        pb[pp] = __builtin_bit_cast(bf16x8, pz); }
    const float rs = 1.0f / sum;
#pragma unroll
    for (int dt = 0; dt < 8; ++dt) {
        f32x4 o4 = (f32x4){0.f, 0.f, 0.f, 0.f};
        s16x4 vl[5], vh[5];
#pragma unroll
        for (int pp = 0; pp < 5; ++pp) {
            LAS unsigned char* vb = lds + DA_V + (16 * w + 32 * pp + 4 * q4 + (r16 >> 2)) * 288 + (16 * dt + 4 * (r16 & 3)) * 2;
            vl[pp] = vtr(vb);
            vh[pp] = vtr(pp < 4 ? vb + 16 * 288 : vb);
        }
        __builtin_amdgcn_sched_barrier(0);
#pragma unroll
        for (int pp = 0; pp < 5; ++pp) o4 = MFMA16(__builtin_shufflevector(vl[pp], vh[pp], 0, 1, 2, 3, 4, 5, 6, 7), pb[pp], o4);
        __builtin_amdgcn_sched_barrier(0);
        u32x2 wv; wv.x = pk2(o4[0] * rs, o4[1] * rs); wv.y = pk2(o4[2] * rs, o4[3] * rs);
        *(u32x2*)(qrow + 16 * dt + 4 * q4) = wv;
    }
    if (q4 == 0) lse[((size_t)sq * SEQ + (size_t)(mq * dil + res)) * 12 + g * 4 + head] = mx + __builtin_amdgcn_logf(sum);
    __syncthreads();
    }
}

DI void xattn_item(LAS unsigned char* lds, bf16* Qx, const bf16* Kmem, const bf16* Vtmem, int b, int item, int tid) {
    const int lane = tid & 63, w = __builtin_amdgcn_readfirstlane(tid >> 6), r16 = lane & 15, q4 = lane >> 4;
    const int qt = item & 63, head = (item >> 6) & 3, sq = item >> 8, mseq = 2 * b + sq;
    const bf16* Kg = Kmem + (size_t)mseq * 256 * 1024 + head * 256;
    const bf16* Vg = Vtmem + (size_t)(mseq * 4 + head) * 256 * 256;
    bf16* qrow = Qx + ((size_t)sq * SEQ + 128 * qt + 16 * w + r16) * DM + head * 256;
    bf16x8 qf[8];
#pragma unroll
    for (int st = 0; st < 8; ++st) qf[st] = *(const bf16x8*)(qrow + 32 * st + 8 * q4);
    {
        u32x4 kreg[16];
#pragma unroll
        for (int it = 0; it < 16; ++it) { const int e = it * 512 + tid, key = e >> 5, ch = e & 31; kreg[it] = *(const u32x4*)(Kg + (size_t)key * 1024 + ch * 8); }
#pragma unroll
        for (int it = 0; it < 16; ++it) { const int e = it * 512 + tid, key = e >> 5, ch = e & 31; *(LAS u32x4*)(lds + key * 528 + ch * 16) = kreg[it]; }
    }
    __syncthreads();
    f32x4 sc[16]; float mx = -1e30f;
#define XA_KREAD(dst, kt_) _Pragma("unroll") for (int st = 0; st < 8; ++st) dst[st] = *(const LAS bf16x8*)(lds + (16 * (kt_) + r16) * 528 + (32 * st + 8 * q4) * 2)
#define XA_TILE(src, kt_) do { f32x4 a4 = (f32x4){0.f, 0.f, 0.f, 0.f}; _Pragma("unroll") for (int st = 0; st < 8; ++st) a4 = MFMA16(src[st], qf[st], a4); \
        _Pragma("unroll") for (int i = 0; i < 4; ++i) mx = fmaxf(mx, a4[i]); sc[kt_] = a4; } while (0)
    {
#pragma unroll
        for (int kt = 0; kt < 16; ++kt) {
            bf16x8 fa[8];
            XA_KREAD(fa, kt); __builtin_amdgcn_sched_barrier(0);
            XA_TILE(fa, kt); __builtin_amdgcn_sched_barrier(0);
        }
    }
    mx = fmaxf(mx, __shfl_xor(mx, 16)); mx = fmaxf(mx, __shfl_xor(mx, 32));
    float sum = 0.f;
#pragma unroll
    for (int kt = 0; kt < 16; ++kt)
#pragma unroll
        for (int i = 0; i < 4; ++i) { const float pv = __builtin_amdgcn_exp2f(sc[kt][i] - mx); sc[kt][i] = pv; sum += pv; }
    sum += __shfl_xor(sum, 16); sum += __shfl_xor(sum, 32);
    bf16x8 pb[8];
#pragma unroll
    for (int pp = 0; pp < 8; ++pp) { u32x4 pz; pz.x = pk2(sc[2 * pp][0], sc[2 * pp][1]); pz.y = pk2(sc[2 * pp][2], sc[2 * pp][3]); pz.z = pk2(sc[2 * pp + 1][0], sc[2 * pp + 1][1]); pz.w = pk2(sc[2 * pp + 1][2], sc[2 * pp + 1][3]);
        pb[pp] = __builtin_bit_cast(bf16x8, pz); }
    {
        u32x4 vreg[16];
#pragma unroll
        for (int it = 0; it < 16; ++it) { const int e = it * 512 + tid, d = e >> 5, ch = e & 31; vreg[it] = *(const u32x4*)(Vg + (size_t)d * 256 + ch * 8); }
        __syncthreads();
#pragma unroll
        for (int it = 0; it < 16; ++it) { const int e = it * 512 + tid, d = e >> 5, ch = e & 31; *(LAS u32x4*)(lds + d * 528 + ch * 16) = vreg[it]; }
    }
    __syncthreads();
    const float rs = __builtin_amdgcn_rcpf(sum);
#define XA_VREAD(dst, dt_) _Pragma("unroll") for (int pp = 0; pp < 8; ++pp) { dst[2 * pp] = *(const LAS s16x4*)(lds + (16 * (dt_) + r16) * 528 + (32 * pp + 4 * q4) * 2); \
        dst[2 * pp + 1] = *(const LAS s16x4*)(lds + (16 * (dt_) + r16) * 528 + (32 * pp + 16 + 4 * q4) * 2); }
#define XA_OTILE(src, dt_) do { f32x4 o4 = (f32x4){0.f, 0.f, 0.f, 0.f}; _Pragma("unroll") for (int pp = 0; pp < 8; ++pp) o4 = MFMA16(__builtin_shufflevector(src[2 * pp], src[2 * pp + 1], 0, 1, 2, 3, 4, 5, 6, 7), pb[pp], o4); \
        u32x2 wv; wv.x = cvtpk(o4[0] * rs, o4[1] * rs); wv.y = cvtpk(o4[2] * rs, o4[3] * rs); *(u32x2*)(qrow + 16 * (dt_) + 4 * q4) = wv; } while (0)
    {
#pragma unroll
        for (int dt = 0; dt < 16; ++dt) {
            s16x4 va[16];
            XA_VREAD(va, dt); __builtin_amdgcn_sched_barrier(0);
            XA_OTILE(va, dt); __builtin_amdgcn_sched_barrier(0);
        }
    }
    __syncthreads();
}

DI void post_row(bf16* P, int m, const bf16* ofr, const bf16* obr, const float* lser, const float* gn, bf16* Urow, int lane) {
    bf16* arow = P + OFF_ATT0 + (size_t)m * 512 + 8 * lane; const bf16* grow = P + OFF_G + (size_t)m * 1024;
    { const int h = lane >> 4; const float l0 = lser[h], l1 = lser[4 + h], l2 = lser[8 + h]; const float mxl = fmaxf(l0, fmaxf(l1, l2));
      float w0 = __builtin_amdgcn_exp2f(l0 - mxl), w1 = __builtin_amdgcn_exp2f(l1 - mxl), w2 = __builtin_amdgcn_exp2f(l2 - mxl); const float rs = 1.0f / (w0 + w1 + w2); w0 *= rs; w1 *= rs; w2 *= rs;
      const u32x4 a = *(const u32x4*)arow, b = *(const u32x4*)(arow + 3 * PE2), c = *(const u32x4*)(arow + 6 * PE2);
      u32x4 o;
      o.x = pk2(w0 * lo_f(a.x) + w1 * lo_f(b.x) + w2 * lo_f(c.x), w0 * hi_f(a.x) + w1 * hi_f(b.x) + w2 * hi_f(c.x));
      o.y = pk2(w0 * lo_f(a.y) + w1 * lo_f(b.y) + w2 * lo_f(c.y), w0 * hi_f(a.y) + w1 * hi_f(b.y) + w2 * hi_f(c.y));
      o.z = pk2(w0 * lo_f(a.z) + w1 * lo_f(b.z) + w2 * lo_f(c.z), w0 * hi_f(a.z) + w1 * hi_f(b.z) + w2 * hi_f(c.z));
      o.w = pk2(w0 * lo_f(a.w) + w1 * lo_f(b.w) + w2 * lo_f(c.w), w0 * hi_f(a.w) + w1 * hi_f(b.w) + w2 * hi_f(c.w));
      *(u32x4*)arow = o; }
    { float o[16];
#pragma unroll
      for (int hlf = 0; hlf < 2; ++hlf) { const u32x4 a = *(const u32x4*)(ofr + 16 * lane + 8 * hlf), b = *(const u32x4*)(obr + 16 * lane + 8 * hlf);
          o[8 * hlf + 0] = lo_f(a.x) + lo_f(b.x); o[8 * hlf + 1] = hi_f(a.x) + hi_f(b.x); o[8 * hlf + 2] = lo_f(a.y) + lo_f(b.y); o[8 * hlf + 3] = hi_f(a.y) + hi_f(b.y);
          o[8 * hlf + 4] = lo_f(a.z) + lo_f(b.z); o[8 * hlf + 5] = hi_f(a.z) + hi_f(b.z); o[8 * hlf + 6] = lo_f(a.w) + lo_f(b.w); o[8 * hlf + 7] = hi_f(a.w) + hi_f(b.w); }
      float ss = 0.f;
#pragma unroll
      for (int i = 0; i < 16; ++i) ss += o[i] * o[i];
      ss += __shfl_xor(ss, 1); ss += __shfl_xor(ss, 2); ss += __shfl_xor(ss, 4);
      const float rstd = rsqrtf(ss * (1.0f / 128.0f) + RMS_EPS);
      const int vc = (16 * lane) & 127;
#pragma unroll
      for (int hlf = 0; hlf < 2; ++hlf) { const u32x4 gsl = *(const u32x4*)(grow + 16 * lane + 8 * hlf);
          const f32x4 g0 = *(const f32x4*)(gn + vc + 8 * hlf), g1 = *(const f32x4*)(gn + vc + 8 * hlf + 4);
          u32x4 wv;
          wv.x = pk2(o[8 * hlf + 0] * rstd * g0[0] * lo_f(gsl.x), o[8 * hlf + 1] * rstd * g0[1] * hi_f(gsl.x));
          wv.y = pk2(o[8 * hlf + 2] * rstd * g0[2] * lo_f(gsl.y), o[8 * hlf + 3] * rstd * g0[3] * hi_f(gsl.y));
          wv.z = pk2(o[8 * hlf + 4] * rstd * g1[0] * lo_f(gsl.z), o[8 * hlf + 5] * rstd * g1[1] * hi_f(gsl.z));
          wv.w = pk2(o[8 * hlf + 6] * rstd * g1[2] * lo_f(gsl.w), o[8 * hlf + 7] * rstd * g1[3] * hi_f(gsl.w));
          *(u32x4*)(Urow + 16 * lane + 8 * hlf) = wv; } }
}

#define XB_TMO      128
#define XB_XCNT(j)  (256  + 64 * (j))
#define XB_XSUB(j)  (1280 + 64 * (j))
#define XB_XGEN(j)  (2304 + 64 * (j))
#define XB_TOP      3328
#define XB_TOPGEN   3392
#define XCD_BAR_WORDS 3456
#define XB_SPIN_CAP (1u << 18)
DI unsigned xb_ld(unsigned* p)              { return __hip_atomic_load(p, __ATOMIC_RELAXED, __HIP_MEMORY_SCOPE_AGENT); }
DI unsigned xb_add(unsigned* p, unsigned v) { return __hip_atomic_fetch_add(p, v, __ATOMIC_RELAXED, __HIP_MEMORY_SCOPE_AGENT); }
DI unsigned xb_xcc_id() { return (unsigned)__builtin_amdgcn_s_getreg((3 << 11) | 20) & 0xFu; }
#define XB_SPIN(cond, bar) do { unsigned _sp = 0; while (cond) { __builtin_amdgcn_s_sleep(1); \
    if ((++_sp & 255u) == 0u) { if (xb_ld(&(bar)[XB_TMO])) break; if (_sp > XB_SPIN_CAP) { atomicAdd(&(bar)[XB_TMO], 1u); break; } } } } while (0)
struct XcdBarrier { unsigned* bar; unsigned x; volatile LAS unsigned* st; };
DI XcdBarrier xcd_barrier_post(unsigned* bar, volatile LAS unsigned* st) {
    XcdBarrier b; b.bar = bar; b.x = xb_xcc_id(); b.st = st;
    if (threadIdx.x == 0) (void)xb_add(&bar[XB_XCNT(b.x)], 1u);
    return b;
}
DI void xcd_barrier_complete(unsigned* bar, unsigned x, unsigned& nloc, unsigned& nx) {
    const unsigned G = gridDim.x * gridDim.y * gridDim.z;
    unsigned sum, cnt, mine, sp = 0u;
    for (;;) {
        sum = 0u; cnt = 0u; mine = 0u;
#pragma unroll
        for (unsigned j = 0; j < 16; ++j) { const unsigned c = xb_ld(&bar[XB_XCNT(j)]); sum += c; cnt += (c > 0u) ? 1u : 0u; mine = (j == x) ? c : mine; }
        if (sum == G) break;
        __builtin_amdgcn_s_sleep(1);
        if ((++sp & 255u) == 0u) { if (xb_ld(&bar[XB_TMO])) break; if (sp > XB_SPIN_CAP) { atomicAdd(&bar[XB_TMO], 1u); break; } }
    }
    nloc = mine > 0u ? mine : 1u; nx = cnt > 0u ? cnt : 1u;
}
DI void xcd_barrier(const XcdBarrier& b) {
    asm volatile("s_waitcnt vmcnt(0)" ::: "memory");
    __syncthreads();
    if (threadIdx.x == 0) {
        unsigned* bar = b.bar;
        __builtin_amdgcn_s_waitcnt(0);
        unsigned nloc = b.st[0], nx = b.st[1];
        if (nloc == 0u) { xcd_barrier_complete(bar, b.x, nloc, nx); b.st[0] = nloc; b.st[1] = nx; }
        const unsigned old = xb_add(&bar[XB_XSUB(b.x)], 1u);
        const unsigned gen = old / nloc;
        if (old + 1u == (gen + 1u) * nloc) {
            __builtin_amdgcn_fence(__ATOMIC_RELEASE, "agent");
            asm volatile("s_waitcnt vmcnt(0)" ::: "memory");
            const unsigned og = xb_add(&bar[XB_TOP], 1u);
            const unsigned tg = og / nx;
            if (og + 1u == (tg + 1u) * nx) xb_add(&bar[XB_TOPGEN], 1u);
            else XB_SPIN(xb_ld(&bar[XB_TOPGEN]) == tg, bar);
            __builtin_amdgcn_fence(__ATOMIC_ACQUIRE, "agent");
            xb_add(&bar[XB_XGEN(b.x)], 1u);
            asm volatile("s_waitcnt vmcnt(0)" ::: "memory");
        } else {
            XB_SPIN(xb_ld(&bar[XB_XGEN(b.x)]) == gen, bar);
            __builtin_amdgcn_fence(__ATOMIC_ACQUIRE, "agent");
            asm volatile("s_waitcnt vmcnt(0)" ::: "memory");
        }
    }
    __syncthreads();
}

struct Args { const float* in[20]; float* out; unsigned char* ws; int ph_lo, ph_hi; };
constexpr int NPB = 11;
constexpr int NPH = 1 + NBATCH * NPB;

__global__ void __launch_bounds__(512, 2) fwd_kernel(Args args) {
    extern __shared__ __attribute__((aligned(16))) unsigned char lds_raw[];
    LAS unsigned char* lds = (LAS unsigned char*)lds_raw;
    const int G = gridDim.x, bx = blockIdx.x;
    const int NGW = G * 8;
    const int wave = __builtin_amdgcn_readfirstlane((int)threadIdx.x >> 6), gw = bx * 8 + wave;
    unsigned char* ws = args.ws;
    const float* x_prompt = args.in[0]; const float* x_sample = args.in[1];
    bf16* W_in = (bf16*)(ws + WS_WIN); bf16* W_ho = (bf16*)(ws + WS_WHO); bf16* W_ao = (bf16*)(ws + WS_WAO); bf16* W_out = (bf16*)(ws + WS_WOUT);
    bf16* W_xq = (bf16*)(ws + WS_WXQ); bf16* W_xkv = (bf16*)(ws + WS_WXKV); bf16* W_xo = (bf16*)(ws + WS_WXO); bf16* W_f1 = (bf16*)(ws + WS_WF1); bf16* W_f2 = (bf16*)(ws + WS_WF2);
    float* LB = (float*)(ws + WS_LB); float* ROPE = (float*)(ws + WS_ROPE); float* SEGD = (float*)(ws + WS_SEGD); float* SEGL = (float*)(ws + WS_SEGL);
    bf16* MEMN = (bf16*)(ws + WS_MEMN); bf16* KMEM = (bf16*)(ws + WS_KMEM); bf16* VTMEM = (bf16*)(ws + WS_VTMEM); float* LSE = (float*)(ws + WS_LSE);
    bf16* U = (bf16*)(ws + WS_U); bf16* P = (bf16*)(ws + WS_P); float* SS = (float*)(ws + WS_SS);
    cg::grid_group grid = cg::this_grid();
    if (threadIdx.x < 2) *(volatile LAS unsigned*)(lds + LDS_BARST + 4 * threadIdx.x) = 0u;
    __syncthreads();
    XcdBarrier xbar = xcd_barrier_post((unsigned*)(ws + WS_CTL), (volatile LAS unsigned*)(lds + LDS_BARST));

    for (int ph = args.ph_lo; ph < args.ph_hi; ++ph) {
#define TID_INIT unsigned ones_ = ~0u; asm volatile("" : "+s"(ones_)); int tid = wave * 64 + (int)__builtin_amdgcn_mbcnt_hi(ones_, __builtin_amdgcn_mbcnt_lo(ones_, 0u)); asm volatile("" : "+v"(tid)); const int lane = tid & 63; (void)lane;
        if (ph == 0) {
            TID_INIT
            LAS float* scr = (LAS float*)(lds + wave * 16384);
            constexpr int I_IN = 16 * (NIN / 32), I_HO = 16 * 32, I_AO = 8 * 32, I_OUT = 16 * 32, I_XQ = 16 * 32, I_XKV = 16 * 64, I_XO = 16 * 32, I_F1 = 16 * 128, I_F2 = 64 * 32;
            constexpr int NITEMS = I_IN + I_HO + I_AO + I_OUT + I_XQ + I_XKV + I_XO + I_F1 + I_F2;
            for (int it = gw; it < NITEMS; it += NGW) {
                int r = it;
                if (r < I_IN) { p0_transpose_item(args.in[5], 1024, NIN, W_in, args.in[4], scr, r, lane); continue; } r -= I_IN;
                if (r < I_HO) { p0_transpose_item(args.in[8], 1024, 1024, W_ho, nullptr, scr, r, lane); continue; } r -= I_HO;
                if (r < I_AO) { p0_transpose_item(args.in[9], 512, 1024, W_ao, nullptr, scr, r, lane); continue; } r -= I_AO;
                if (r < I_OUT) { p0_transpose_item(args.in[10], 1024, 1024, W_out, nullptr, scr, r, lane); continue; } r -= I_OUT;
                if (r < I_XQ) { p0_transpose_item(args.in[13], 1024, 1024, W_xq, args.in[11], scr, r, lane); continue; } r -= I_XQ;
                if (r < I_XKV) { p0_transpose_item(args.in[14], 1024, 2048, W_xkv, args.in[12], scr, r, lane); continue; } r -= I_XKV;
                if (r < I_XO) { p0_transpose_item(args.in[15], 1024, 1024, W_xo, nullptr, scr, r, lane); continue; } r -= I_XO;
                if (r < I_F1) { p0_transpose_item(args.in[17], 1024, FF, W_f1, args.in[16], scr, r, lane); continue; } r -= I_F1;
                p0_transpose_item(args.in[18], FF, 1024, W_f2, nullptr, scr, r, lane);
            }
            const int gt = bx * 512 + tid, NGT = G * 512;
            for (int i = gt; i < 2048; i += NGT) { const int d = i >> 10, f = i & 1023; const float l0 = args.in[6][d * 2048 + f], l1 = args.in[6][d * 2048 + 1024 + f]; LB[i] = 1.0f / (1.0f + __expf(l1 - l0)); }
            for (int i = gt; i < SEQ * 16; i += NGT) {
                const int pos = i >> 4, fi = i & 15;
                const float invt[16] = {1.0f, 0.44036659598350525f, 0.1939227432012558f, 0.08539710193872452f, 0.03760603070259094f, 0.016560440883040428f, 0.007292664609849453f, 0.0032114461064338684f,
                                        0.0014142135623842478f, 0.0006227724370546639f, 0.00027424818836152554f, 0.00012076973507646471f, 5.3182957344688475e-05f, 2.34199997066753e-05f, 1.0313385246263351e-05f, 4.541670477919979e-06f};
                float inv = invt[0];
#pragma unroll
                for (int k = 1; k < 16; ++k) inv = (fi == k) ? invt[k] : inv;
                const float x = (float)pos * inv;
                const float kq = rintf(x * 0.63661977236758134308f);
                float r = fmaf(-kq, 1.5707855225e+00f, x); r = fmaf(-kq, 1.0804273188e-05f, r); r = fmaf(-kq, 6.0770999344e-11f, r);
                const float r2 = r * r;
                const float sn = r + r * r2 * (-1.0f / 6 + r2 * (1.0f / 120 + r2 * (-1.0f / 5040 + r2 * (1.0f / 362880))));
                const float cn = 1.0f + r2 * (-0.5f + r2 * (1.0f / 24 + r2 * (-1.0f / 720 + r2 * (1.0f / 40320 + r2 * (-1.0f / 3628800)))));
                const int qd = ((int)kq) & 3;
                const float c = (qd == 0) ? cn : (qd == 1) ? -sn : (qd == 2) ? -cn : sn;
                const float s = (qd == 0) ? sn : (qd == 1) ? cn : (qd == 2) ? -sn : -cn;
                ROPE[2 * i] = c; ROPE[2 * i + 1] = s;
            }
            for (int m = gw; m < NSEQ * NMEM; m += NGW) { const float* src = (m < 512) ? args.in[2] + (size_t)m * DM : args.in[3] + (size_t)(m - 512) * DM; norm_row_bf16(src, MEMN + (size_t)m * DM, lane); }
            for (int m = gw; m < BROWS; m += NGW) norm_row_bf16(x_prompt + (size_t)m * DM, U + (size_t)m * DM, lane);
        } else {
            const int b = (ph - 1) / NPB, pp = (ph - 1) % NPB + 1; const int j = (pp <= 6) ? pp : (pp == 7 ? 8 : (pp == 8 ? 10 : pp + 3)); const bool rep2 = false;
            const float* xb = (b == 0) ? x_prompt : x_sample + (size_t)(b - 1) * BROWS * DM;
            float* hb = args.out + (size_t)b * BROWS * DM;
            bf16* Of = (bf16*)hb; bf16* Ob = Of + (size_t)BROWS * DM;
            if (j == 1) {
                TID_INIT
                { pg8::Gemm g{U, W_in, BROWS, NIN, DM, DM}; pg8::StaticOrder S; S.init(BROWS, NIN, G, bx); pg8::EpiIn E{P, LB, ROPE};
                  pg8::gemm_phase<pg8::EpiIn, true>(lds, g, S, E, tid); }
                if (b == 0) { pg8::Gemm g{MEMN, W_xkv, NSEQ * NMEM, 2048, DM, DM}; pg8::StaticOrder S; S.init(NSEQ * NMEM, 2048, G, (bx + G / 2) % G); pg8::EpiKV E{KMEM, VTMEM};
                  pg8::gemm_phase<pg8::EpiKV, true>(lds, g, S, E, tid); }
            } else if (j == 2) {
                TID_INIT
                for (int it = bx; it < 256; it += G) hgrn_item<1>(lds, P, Of, Ob, SEGL, SEGD, it, tid);
                { const int vcu = (G % 8 == 0) ? (bx % 8) * (G / 8) + bx / 8 : bx;
                  dattn_items(lds, P, LSE, vcu, G, 1536, tid); }
            } else if (j == 3) {
                TID_INIT
                for (int it = bx; it < 256; it += G) hgrn_item<2>(lds, P, Of, Ob, SEGL, SEGD, it, tid);
            } else if (j == 4) {
                TID_INIT
                for (int m = gw; m < BROWS; m += NGW) post_row(P, m, Of + (size_t)m * DM, Ob + (size_t)m * DM, LSE + (size_t)m * 12, args.in[7], U + (size_t)m * DM, lane);
            } else if (j == 5) {
                TID_INIT
                { pg8::Gemm g{U, W_ho, BROWS, DM, DM, DM}; pg8::StaticOrder S; S.init(BROWS, DM, G, bx); pg8::EpiY<1> E{P}; pg8::gemm_phase<pg8::EpiY<1>, true>(lds, g, S, E, tid); }
                { pg8::Gemm g{P + OFF_ATT0, W_ao, BROWS, DM, 512, 512}; pg8::StaticOrder S; S.init(BROWS, DM, G, bx); pg8::EpiY<2> E{P}; pg8::gemm_phase<pg8::EpiY<2>, true>(lds, g, S, E, tid); }
            } else if (j == 6 || j == 10 || j == 13) {
                TID_INIT
                pg8::StaticOrder S; S.init(BROWS, DM, G, bx);
                if (j == 6) { pg8::Gemm g{P + OFF_GH, W_out, BROWS, DM, DM, 1024}; pg8::EpiRes<0> E{xb, nullptr, U, SS}; pg8::gemm_phase<pg8::EpiRes<0>, true>(lds, g, S, E, tid); }
                else if (j == 10) { pg8::Gemm g{P, W_xo, BROWS, DM, DM, DM}; pg8::EpiRes<1> E{nullptr, nullptr, U, SS + (size_t)BROWS * 16}; pg8::gemm_phase<pg8::EpiRes<1>, true>(lds, g, S, E, tid); }
                else { pg8::Gemm g{P, W_f2, BROWS, DM, FF, FF}; pg8::EpiRes<2> E{nullptr, hb, U, SS + (size_t)2 * BROWS * 16}; pg8::gemm_phase<pg8::EpiRes<2>, true>(lds, g, S, E, tid); }
            } else if (j == 7 || j == 11) {
                TID_INIT
                for (int m = gw; m < BROWS; m += NGW) norm_row_bf16(hb + (size_t)m * DM, U + (size_t)m * DM, lane);
            } else if (j == 8) {
                TID_INIT
                pg8::Gemm g{U, W_xq, BROWS, DM, DM, DM}; pg8::StaticOrder S; S.init(BROWS, DM, G, bx); pg8::EpiBf<0> E{P, DM, QSCALE_X, SS}; pg8::gemm_phase<pg8::EpiBf<0>, true>(lds, g, S, E, tid);
                asm volatile("s_waitcnt vmcnt(0)" ::: "memory"); __syncthreads();
                { pg8::Unit u0;
#pragma nounroll
                  for (int e = 0; S.next(e >> 1, u0); ++e)
                      xattn_item(lds, P, KMEM, VTMEM, b, ((u0.pm >> 5) * 4 + u0.pn) * 64 + 2 * (u0.pm & 31) + (e & 1), tid); }
            } else if (j == 12) {
                TID_INIT
                pg8::Gemm g{U, W_f1, BROWS, FF, DM, DM}; pg8::StaticOrder S; S.init(BROWS, FF, G, bx, 8); pg8::EpiBf<1> E{P, FF, 1.0f, SS + (size_t)BROWS * 16}; pg8::gemm_phase<pg8::EpiBf<1>, true>(lds, g, S, E, tid);
            } else {
                TID_INIT
                for (int m = gw; m < BROWS; m += NGW) final_row_ss(hb + (size_t)m * DM, args.in[19], SS + ((size_t)2 * BROWS + m) * 16, lane);
                if (b + 1 < NBATCH) { const float* xn = x_sample + (size_t)b * BROWS * DM; for (int m = gw; m < BROWS; m += NGW) norm_row_bf16(xn + (size_t)m * DM, U + (size_t)m * DM, lane); }
            }
        }
        if (ph + 1 < args.ph_hi) {
            if (args.ph_lo < 0) { __threadfence(); grid.sync(); }
            xcd_barrier(xbar);
        }
        else __syncthreads();
    }
}

extern "C" void kernel_launch(void* const* d_in, const int* in_sizes, int n_in, void* d_out, int out_size, void* d_ws, size_t ws_size, hipStream_t stream) {
    static int grid = 0;
    if (grid == 0) {
        if (n_in != 20 || ws_size < WS_END) { fprintf(stderr, "kernel_launch: unexpected n_in %d / ws_size %zu\n", n_in, ws_size); grid = -1; return; }
        int dev = 0, cus = 0, per_cu = 0;
        hipGetDevice(&dev); hipDeviceGetAttribute(&cus, hipDeviceAttributeMultiprocessorCount, dev);
        if (hipFuncSetAttribute((const void*)fwd_kernel, hipFuncAttributeMaxDynamicSharedMemorySize, LDS_BYTES) != hipSuccess) { fprintf(stderr, "kernel_launch: hipFuncSetAttribute failed\n"); grid = -1; return; }
        hipOccupancyMaxActiveBlocksPerMultiprocessor(&per_cu, (const void*)fwd_kernel, 512, LDS_BYTES);
        (void)hipGetLastError();
        if (per_cu < 1) per_cu = 1;
        grid = cus;
        fprintf(stderr, "kernel_launch: cus %d per_cu %d grid %d\n", cus, per_cu, grid);
    }
    if (grid < 0) return;
    Args a{};
    for (int i = 0; i < 20; ++i) a.in[i] = (const float*)d_in[i];
    a.out = (float*)d_out; a.ws = (unsigned char*)d_ws;
#if ONE_LAUNCH
    if (hipMemsetAsync((char*)d_ws + WS_CTL, 0, CTL_BYTES, stream) != hipSuccess) { fprintf(stderr, "kernel_launch: memset failed\n"); return; }
    a.ph_lo = 0; a.ph_hi = NPH;
    void* kargs[] = {&a};
    hipError_t e = hipLaunchCooperativeKernel((const void*)fwd_kernel, dim3(grid), dim3(512), kargs, LDS_BYTES, stream);
    if (e != hipSuccess) fprintf(stderr, "cooperative launch failed: %s (grid %d)\n", hipGetErrorString(e), grid);
#else
    for (int ph = 0; ph < NPH; ++ph) {
        a.ph_lo = ph; a.ph_hi = ph + 1;
        hipLaunchKernelGGL(fwd_kernel, dim3(grid), dim3(512), LDS_BYTES, stream, a);
    }
#endif
}
```
